# Optimizing an MI355X kernel written in HIP

```python
import math, functools
import jax, jax.numpy as jnp
from jax import lax
import numpy as np

D_MODEL = 1024
BATCH = 8
SEQ = 4096
DEPTH = 2

GRID_W = 64
CTX_LEN = 256

ATT_HEADS = 8
ATT_KV_HEADS = 2
GQA_GROUP = ATT_HEADS // ATT_KV_HEADS
HEAD_DIM = 64
ATT_Q_DIM = ATT_HEADS * HEAD_DIM
ATT_KV_DIM = ATT_KV_HEADS * HEAD_DIM
WINDOW = 128
ATT_BLOCK = 128
ATT_SCALE = HEAD_DIM ** -0.5
ROPE_BASE = 10000.0
ROPE_FREQS = HEAD_DIM // 4
RWKV_HEADS = 8
RWKV_HEAD = 64
RWKV_DIM = RWKV_HEADS * RWKV_HEAD
DECAY_LORA = 64
ICLR_LORA = 64
VRES_LORA = 32
GATE_LORA = 128
SHIFT_WIDTH = 3
GN_EPS = 64e-5
RWKV_SPLITS = (RWKV_DIM, RWKV_DIM, RWKV_DIM, DECAY_LORA, ICLR_LORA, GATE_LORA)
RWKV_IN = sum(RWKV_SPLITS)
RWKV_CUTS = tuple(np.cumsum(RWKV_SPLITS)[:-1].tolist())
CHUNK = 128
SGU_GROUPS = 4
SGU_DIM = 512
SGU_GROUP_DIM = SGU_DIM // SGU_GROUPS
N_BRANCH = 3
FFN_HIDDEN = -(-(8 * D_MODEL) // (3 * 256)) * 256
EPS = 1e-6
IN_SPLITS = (ATT_Q_DIM, ATT_KV_DIM, ATT_KV_DIM, RWKV_IN, 2 * SGU_DIM, N_BRANCH * D_MODEL)
IN_DIM = sum(IN_SPLITS)
IN_CUTS = tuple(np.cumsum(IN_SPLITS)[:-1].tolist())

kernel_name = 'hybrid_prefix_dit_attn_rwkv7_sgu'


def rmsnorm(t, gain):
    t32 = t.astype(jnp.float32)
    return (t32 * lax.rsqrt(jnp.mean(t32 * t32, -1, keepdims=True) + EPS) * gain).astype(t.dtype)


def layernorm(t, w, b):
    t32 = t.astype(jnp.float32)
    mu = jnp.mean(t32, -1, keepdims=True)
    var = jnp.mean(jnp.square(t32 - mu), -1, keepdims=True)
    return ((t32 - mu) * lax.rsqrt(var + EPS) * w + b).astype(t.dtype)


def modulate(h, shift, scale):
    return h * (1.0 + scale) + shift


def axial_rope(n):
    rows = n // GRID_W
    row = jnp.repeat(jnp.arange(rows), GRID_W).astype(jnp.float32)
    col = jnp.tile(jnp.arange(GRID_W), rows).astype(jnp.float32)
    inv = ROPE_BASE ** (-jnp.arange(ROPE_FREQS, dtype=jnp.float32) / ROPE_FREQS)
    ang = jnp.concatenate([row[:, None] * inv, col[:, None] * inv], -1)
    return jnp.cos(ang), jnp.sin(ang)


def apply_rope(t, cos, sin):
    t32 = t.astype(jnp.float32)
    t1, t2 = jnp.split(t32, 2, -1)
    cos, sin = cos[None, :, None, :], sin[None, :, None, :]
    return jnp.concatenate([t1 * cos - t2 * sin, t1 * sin + t2 * cos], -1).astype(t.dtype)


def head_rmsnorm(p, n_heads, gain):
    return rmsnorm(p.reshape(p.shape[:-1] + (n_heads, HEAD_DIM)), gain)


def sink_attend(qg, keys, vals, masks, sink):
    B, Q = qg.shape[:2]
    logits = []
    for kt, m in zip(keys, masks):
        s = jnp.einsum('bqhgd,bkhd->bhgqk', qg, kt).astype(jnp.float32) * ATT_SCALE
        if m is not None:
            s = jnp.where(m, s, -jnp.inf)
        logits.append(s)
    sink_col = sink.astype(jnp.float32).reshape(ATT_KV_HEADS, GQA_GROUP, 1, 1)
    logits.append(jnp.broadcast_to(sink_col, (B, ATT_KV_HEADS, GQA_GROUP, Q, 1)))
    p = jax.nn.softmax(jnp.concatenate(logits, -1), axis=-1)
    out, start = None, 0
    for vt in vals:
        n = vt.shape[1]
        o = jnp.einsum('bhgqk,bkhd->bqhgd', p[..., start:start + n].astype(vt.dtype), vt)
        out = o if out is None else out + o
        start += n
    return out


def _band(t, nb):
    B, _, H, hd = t.shape
    tb = jnp.pad(t.reshape(B, nb, ATT_BLOCK, H, hd), ((0, 0), (1, 1), (0, 0), (0, 0), (0, 0)))
    band = jnp.concatenate([tb[:, :-2], tb[:, 1:-1], tb[:, 2:]], axis=2)
    return jnp.moveaxis(band, 1, 0)


def window_attention(q, k, v, kc, vc, sink):
    B, N = q.shape[:2]
    nb = N // ATT_BLOCK
    qb = jnp.moveaxis(q.reshape(B, nb, ATT_BLOCK, ATT_KV_HEADS, GQA_GROUP, HEAD_DIM), 1, 0)
    kb, vb = _band(k, nb), _band(v, nb)
    offs = jnp.arange(3 * ATT_BLOCK) - ATT_BLOCK
    rel = offs[None, :] - jnp.arange(ATT_BLOCK)[:, None]
    key_pos = jnp.arange(nb)[:, None] * ATT_BLOCK + offs[None, :]
    mask = (jnp.abs(rel) <= WINDOW)[None] & ((key_pos >= 0) & (key_pos < N))[:, None, :]

    def block(args):
        qi, ki, vi, mi = args
        return sink_attend(qi, (ki, kc), (vi, vc), (mi, None), sink)

    out = lax.map(block, (qb, kb, vb, mask))
    return jnp.moveaxis(out, 0, 1).reshape(B, N, ATT_Q_DIM)


def context_attention(qc, kc, vc, sink):
    B, L = qc.shape[:2]
    qg = qc.reshape(B, L, ATT_KV_HEADS, GQA_GROUP, HEAD_DIM)
    return sink_attend(qg, (kc,), (vc,), (None,), sink).reshape(B, L, ATT_Q_DIM)


def short_conv(t, w):
    T = t.shape[1]
    half = SHIFT_WIDTH // 2
    tp = jnp.pad(t, ((0, 0), (half, half), (0, 0)))
    return sum(tp[:, i:i + T] * w[i] for i in range(SHIFT_WIDTH))


def _time_major(t):
    t = jnp.stack([t[0], jnp.flip(t[1], axis=1)])
    return jnp.moveaxis(t, 2, 0)


def _rwkv_step(S, inp, emit):
    r, w, k, v, a, b = inp
    sa = jnp.einsum('dbhvk,dbhk->dbhv', S, a)
    S = S * w[..., None, :] + sa[..., :, None] * b[..., None, :] + v[..., :, None] * k[..., None, :]
    return S, (jnp.einsum('dbhvk,dbhk->dbhv', S, r) if emit else None)


def rwkv_time_mix(r, k, v, xw, xa, xg, state0, lp, readout):
    f32 = jnp.float32
    B, T, C = r.shape
    heads = lambda t: t.reshape(t.shape[:-1] + (RWKV_HEADS, RWKV_HEAD))
    kk = heads((k * lp['k_k']).astype(f32))
    kk = kk * lax.rsqrt(jnp.sum(kk * kk, -1, keepdims=True) + 1e-12)
    w_pre = lp['w0'][:, None, None, :] + jnp.einsum('btr,drc->dbtc', jnp.tanh(xw), lp['w_up'])
    decay = jnp.exp(-jnp.exp(-jax.nn.softplus(-w_pre.astype(f32)) - 0.5))
    a = jax.nn.sigmoid((lp['a0'][:, None, None, :] + jnp.einsum('btr,drc->dbtc', xa, lp['a_up'])).astype(f32))
    k_dir = k.astype(f32)[None] * (1.0 + (a - 1.0) * lp['k_a'])
    rh, vh, kdh = heads(r.astype(f32)), heads(v.astype(f32)), heads(k_dir)
    both = lambda t: jnp.stack([t, t])
    seqs = (both(rh), heads(decay), kdh, both(vh), both(-kk), kk[None] * heads(a))
    state, ys = lax.scan(functools.partial(_rwkv_step, emit=readout), state0,
                         tuple(_time_major(t) for t in seqs))
    if not readout:
        return None, state
    y = jnp.moveaxis(ys[:, 0] + jnp.flip(ys[:, 1], axis=0), 0, 1)
    mu = jnp.mean(y, -1, keepdims=True)
    var = jnp.mean(jnp.square(y - mu), -1, keepdims=True)
    y = ((y - mu) * lax.rsqrt(var + GN_EPS)).reshape(B, T, C) * lp['ln_w'] + lp['ln_b']
    bonus = jnp.einsum('bthn,dbthn,hn->bth', rh, kdh, lp['r_k'])[..., None] * vh
    g = jax.nn.sigmoid(xg) @ lp['g_up']
    return ((y + bonus.reshape(B, T, C)) * g).astype(r.dtype), state


def value_residual(v, v_first, h, down, up, bias):
    return v + (v_first - v) * jax.nn.sigmoid(bias + (h @ down) @ up)


def spatial_gating(p_sg, lp):
    u, vg = jnp.split(jax.nn.gelu(p_sg), 2, -1)
    B, T, _ = u.shape
    vn = layernorm(vg, lp['sgu_ln_w'], lp['sgu_ln_b'])
    vc = vn.reshape(B, T // CHUNK, CHUNK, SGU_GROUPS, SGU_GROUP_DIM)
    s = jnp.einsum('gpq,bnqgc->bnpgc', lp['sgu_w'], vc) + lp['sgu_b'].T[None, None, :, :, None]
    return u * s.reshape(B, T, SGU_DIM)


def merge_branches(o_attn, o_rwkv, o_sgu, p_gate, lp):
    ga, gb, gc = jnp.split(jax.nn.sigmoid(p_gate), N_BRANCH, -1)
    m = ga * (o_attn @ lp['w_o_attn']) + gb * (o_rwkv @ lp['w_o_rwkv']) + gc * (o_sgu @ lp['w_o_sgu'])
    return m @ lp['w_out']


def token_mixers(h, hc, lp, rope, v_first, vres, last):
    pq, pk, pv, p_rw, p_sg, p_gt = jnp.split(h @ lp['w_in'], IN_CUTS, -1)
    cq, ck, cv, c_rw, c_sg, c_gt = jnp.split(hc @ lp['w_in'], IN_CUTS, -1)
    B, L = hc.shape[:2]
    q = apply_rope(head_rmsnorm(pq, ATT_HEADS, lp['q_gain']), *rope)
    k = apply_rope(head_rmsnorm(pk, ATT_KV_HEADS, lp['k_gain']), *rope)
    v = pv.reshape(pv.shape[:-1] + (ATT_KV_HEADS, HEAD_DIM))
    kc = head_rmsnorm(ck, ATT_KV_HEADS, lp['k_gain'])
    vc = cv.reshape(B, L, ATT_KV_HEADS, HEAD_DIM)
    o_attn = window_attention(q, k, v, kc, vc, lp['sink'])
    r, kr, vr, xw, xa, xg = jnp.split(short_conv(p_rw, lp['conv']), RWKV_CUTS, -1)
    rc, krc, vrc, xwc, xac, xgc = jnp.split(short_conv(c_rw, lp['conv']), RWKV_CUTS, -1)
    if vres is not None:
        vr = value_residual(vr, v_first[0], h, *vres)
        vrc = value_residual(vrc, v_first[1], hc, *vres)
    state0 = jnp.zeros((2, B, RWKV_HEADS, RWKV_HEAD, RWKV_HEAD), jnp.float32)
    oc_rwkv, state_c = rwkv_time_mix(rc, krc, vrc, xwc, xac, xgc, state0, lp, not last)
    o_rwkv, _ = rwkv_time_mix(r, kr, vr, xw, xa, xg, state_c, lp, True)
    o_sgu = spatial_gating(p_sg, lp)
    mix = merge_branches(o_attn, o_rwkv, o_sgu, p_gt, lp)
    mix_c = None
    if not last:
        qc = head_rmsnorm(cq, ATT_HEADS, lp['q_gain'])
        mix_c = merge_branches(context_attention(qc, kc, vc, lp['sink']), oc_rwkv,
                               spatial_gating(c_sg, lp), c_gt, lp)
    return mix, mix_c, (vr, vrc)


def swiglu(h, w1, w3, w2):
    return (jax.nn.silu(h @ w1) * (h @ w3)) @ w2


def setup_inputs(seed: int = 0) -> dict:
    key = jax.random.key(seed)
    ks = list(jax.random.split(key, 48))
    nrm = lambda shape, scale: jax.random.normal(ks.pop(), shape, jnp.float32) * scale
    D, L, C, F = D_MODEL, DEPTH, RWKV_DIM, FFN_HIDDEN
    centre = jnp.eye(SHIFT_WIDTH, dtype=jnp.float32)[SHIFT_WIDTH // 2][None, :, None]
    return {
        'x': nrm((BATCH, SEQ, D), 1.0),
        'c': nrm((BATCH, D), 1.0),
        'ctx': nrm((BATCH, CTX_LEN, D), 1.0),
        'c_ctx': nrm((D,), 1.0),
        'w_mod': nrm((L, D, 6 * D), 0.3 * D ** -0.5),
        'b_mod': nrm((L, 6 * D), 0.02),
        'norm_mix': 1.0 + nrm((L, D), 0.05),
        'norm_ffn': 1.0 + nrm((L, D), 0.05),
        'w_in': nrm((L, D, IN_DIM), D ** -0.5),
        'q_gain': 1.0 + nrm((L, HEAD_DIM), 0.1),
        'k_gain': 1.0 + nrm((L, HEAD_DIM), 0.1),
        'attn_sink': nrm((L, ATT_HEADS), 0.5),
        'rwkv_conv': centre + nrm((L, SHIFT_WIDTH, RWKV_IN), 0.2),
        'rwkv_w0': jax.random.uniform(ks.pop(), (L, 2, C), jnp.float32, -6.0, 0.0),
        'rwkv_w_up': nrm((L, 2, DECAY_LORA, C), 0.5 * DECAY_LORA ** -0.5),
        'rwkv_a0': nrm((L, 2, C), 0.1),
        'rwkv_a_up': nrm((L, 2, ICLR_LORA, C), 0.5 * ICLR_LORA ** -0.5),
        'rwkv_k_k': 0.85 + nrm((L, C), 0.05),
        'rwkv_k_a': 1.0 + nrm((L, C), 0.05),
        'rwkv_r_k': nrm((L, RWKV_HEADS, RWKV_HEAD), 0.1),
        'rwkv_g_up': nrm((L, GATE_LORA, C), GATE_LORA ** -0.5),
        'rwkv_ln_w': 1.0 + nrm((L, C), 0.05),
        'rwkv_ln_b': nrm((L, C), 0.02),
        'rwkv_vres_down': nrm((L - 1, D, VRES_LORA), D ** -0.5),
        'rwkv_vres_up': nrm((L - 1, VRES_LORA, C), VRES_LORA ** -0.5),
        'rwkv_vres_b': nrm((L - 1, C), 0.1),
        'sgu_ln_w': 1.0 + nrm((L, SGU_DIM), 0.05),
        'sgu_ln_b': nrm((L, SGU_DIM), 0.02),
        'sgu_w': nrm((L, SGU_GROUPS, CHUNK, CHUNK), CHUNK ** -0.5),
        'sgu_b': 1.0 + nrm((L, SGU_GROUPS, CHUNK), 0.1),
        'w_o_attn': nrm((L, ATT_Q_DIM, D), ATT_Q_DIM ** -0.5),
        'w_o_rwkv': nrm((L, C, D), C ** -0.5),
        'w_o_sgu': nrm((L, SGU_DIM, D), SGU_DIM ** -0.5),
        'w_out': nrm((L, D, D), D ** -0.5),
        'ffn_w1': nrm((L, D, F), D ** -0.5),
        'ffn_w3': nrm((L, D, F), D ** -0.5),
        'ffn_w2': nrm((L, F, D), F ** -0.5),
    }


def reference(x, c, ctx, c_ctx, w_mod, b_mod, norm_mix, norm_ffn, w_in, q_gain, k_gain, attn_sink,
              rwkv_conv, rwkv_w0, rwkv_w_up, rwkv_a0, rwkv_a_up, rwkv_k_k, rwkv_k_a, rwkv_r_k, rwkv_g_up,
              rwkv_ln_w, rwkv_ln_b, rwkv_vres_down, rwkv_vres_up, rwkv_vres_b,
              sgu_ln_w, sgu_ln_b, sgu_w, sgu_b, w_o_attn, w_o_rwkv, w_o_sgu, w_out,
              ffn_w1, ffn_w3, ffn_w2):
    rope = axial_rope(x.shape[1])
    xc = ctx
    v_first = None
    for l in range(DEPTH):
        last = l == DEPTH - 1
        lp = {
            'w_in': w_in[l], 'q_gain': q_gain[l], 'k_gain': k_gain[l], 'sink': attn_sink[l],
            'conv': rwkv_conv[l], 'w0': rwkv_w0[l], 'w_up': rwkv_w_up[l], 'a0': rwkv_a0[l],
            'a_up': rwkv_a_up[l], 'k_k': rwkv_k_k[l], 'k_a': rwkv_k_a[l], 'r_k': rwkv_r_k[l],
            'g_up': rwkv_g_up[l], 'ln_w': rwkv_ln_w[l], 'ln_b': rwkv_ln_b[l],
            'sgu_ln_w': sgu_ln_w[l], 'sgu_ln_b': sgu_ln_b[l], 'sgu_w': sgu_w[l], 'sgu_b': sgu_b[l],
            'w_o_attn': w_o_attn[l], 'w_o_rwkv': w_o_rwkv[l], 'w_o_sgu': w_o_sgu[l], 'w_out': w_out[l],
        }
        vres = None if l == 0 else (rwkv_vres_down[l - 1], rwkv_vres_up[l - 1], rwkv_vres_b[l - 1])
        mod = jax.nn.silu(c) @ w_mod[l] + b_mod[l]
        mod_c = jax.nn.silu(c_ctx) @ w_mod[l] + b_mod[l]
        sh1, sc1, g1, sh2, sc2, g2 = jnp.split(mod[:, None, :], 6, axis=-1)
        csh1, csc1, cg1, csh2, csc2, cg2 = jnp.split(mod_c[None, None, :], 6, axis=-1)
        h = modulate(rmsnorm(x, norm_mix[l]), sh1, sc1)
        hc = modulate(rmsnorm(xc, norm_mix[l]), csh1, csc1)
        mix, mix_c, v_pair = token_mixers(h, hc, lp, rope, v_first, vres, last)
        if l == 0:
            v_first = v_pair
        x = x + g1 * mix
        h = modulate(rmsnorm(x, norm_ffn[l]), sh2, sc2)
        x = x + g2 * swiglu(h, ffn_w1[l], ffn_w3[l], ffn_w2[l])
        if not last:
            xc = xc + cg1 * mix_c
            hc = modulate(rmsnorm(xc, norm_ffn[l]), csh2, csc2)
            xc = xc + cg2 * swiglu(hc, ffn_w1[l], ffn_w3[l], ffn_w2[l])
    return x
```

```cpp
#include <hip/hip_runtime.h>
#include <hip/hip_cooperative_groups.h>
#include <cstdio>
namespace cg = cooperative_groups;

#define LAS __attribute__((address_space(3)))
typedef unsigned short bf16_t;
typedef short bf16x8 __attribute__((ext_vector_type(8)));
typedef short bf16x4 __attribute__((ext_vector_type(4)));
typedef float f32x4 __attribute__((ext_vector_type(4)));
typedef float f32x2 __attribute__((ext_vector_type(2)));

constexpr int NROW = 34816, HROWS = 17408, DM = 1024, LDB = 2688;
constexpr int C_RKV = 640, C_SGU = 2176;
constexpr int FF = 2816;

constexpr size_t OFF_WIN1 = 0, OFF_WGATE = 7864320, OFF_WO3 = 14155776, OFF_WOUT = 17301504, OFF_W13 = 19398656, OFF_W2 = 30932992,
                 OFF_WGL = 36700160, OFF_WWA = 37486592, OFF_WSGU = 37748736, OFF_MOD = 37879808, OFF_ROPE = 38322176, OFF_XSC = 39370752,
                 OFF_V0 = 47759360, OFF_RINV = 83410944, OFF_BIG = 84525056, OFF_AL = 271695872, OFF_VNT = OFF_AL + 17825792,
                 OFF_VT = OFF_VNT + 35651584, OFF_B = 342999040, WS_TOTAL = 504545280;
constexpr size_t OFF_M = OFF_AL, OFF_U = OFF_BIG;
constexpr size_t B_HH = 0, B_QKV = 35651584, B_RW = 62390272, B_SG = 124780544, B_HD = 160432128;
constexpr size_t B_G = 0, B_ASUM = 35651584, B_Y = 71303168;
constexpr size_t B_GATE = 35651584;

struct P {
    const float *x, *c, *ctx, *c_ctx, *w_mod, *b_mod, *norm_mix, *norm_ffn, *w_in, *q_gain, *k_gain, *attn_sink, *rwkv_conv, *rwkv_w0, *rwkv_w_up,
        *rwkv_a0, *rwkv_a_up, *rwkv_k_k, *rwkv_k_a, *rwkv_r_k, *rwkv_g_up, *rwkv_ln_w, *rwkv_ln_b, *vres_down, *vres_up, *vres_b, *sgu_ln_w, *sgu_ln_b,
        *sgu_w, *sgu_b, *w_o_attn, *w_o_rwkv, *w_o_sgu, *w_out, *ffn_w1, *ffn_w3, *ffn_w2;
    float* out;
    unsigned char* ws;
};


typedef const __attribute__((address_space(4))) P CP;
#define PREF CP&
__device__ __forceinline__ int ltid() { int t = threadIdx.x; asm volatile("" : "+v"(t)); return t; }
__device__ __forceinline__ f32x4 zf4() { float z = 0.f; asm volatile("" : "+v"(z)); return (f32x4){z, z, z, z}; }
__device__ __forceinline__ int lbid() { int t = blockIdx.x; asm volatile("" : "+s"(t)); return t; }
__device__ __forceinline__ CP* kargs() { CP* k = (CP*)__builtin_amdgcn_kernarg_segment_ptr(); asm volatile("" : "+s"(k)); return k; }

__shared__ __attribute__((aligned(16))) unsigned char smem[131072];

__device__ __forceinline__ bf16_t f2bf(float f) { unsigned u = __float_as_uint(f); u += 0x7FFFu + ((u >> 16) & 1u); return (bf16_t)(u >> 16); }
__device__ __forceinline__ float bf2f(bf16_t b) { return __uint_as_float(((unsigned)b) << 16); }
__device__ __forceinline__ float bfs(short b) { return __uint_as_float(((unsigned)(unsigned short)b) << 16); }
__device__ __forceinline__ unsigned pk2(float lo, float hi) { return (unsigned)f2bf(lo) | ((unsigned)f2bf(hi) << 16); }
__device__ __forceinline__ float sigm(float x) { return 1.0f / (1.0f + __expf(-x)); }
__device__ __forceinline__ float gelu_t(float x) { float u = 0.7978845608f * (x + 0.044715f * x * x * x); float t = 1.0f - 2.0f / (1.0f + __expf(2.0f * u)); return 0.5f * x * (1.0f + t); }
__device__ __forceinline__ float wsum(float v) { for (int o = 32; o > 0; o >>= 1) v += __shfl_xor(v, o); return v; }
__device__ __forceinline__ void rowinfo(int r, int& b, int& t, bool& isctx) {
    int hf = r >= HROWS ? 1 : 0, rr = r - hf * HROWS;
    if (rr < 16384) { isctx = false; b = hf * 4 + (rr >> 12); t = rr & 4095; } else { isctx = true; rr -= 16384; b = hf * 4 + (rr >> 8); t = rr & 255; }
}
__device__ __forceinline__ int seg_lat(int b) { return (b >> 2) * HROWS + (b & 3) * 4096; }
__device__ __forceinline__ int seg_ctx(int b) { return (b >> 2) * HROWS + 16384 + (b & 3) * 256; }
__device__ __forceinline__ float dppf(float x, int) = delete;
#define DPP_F(x, ctrl) __int_as_float(__builtin_amdgcn_update_dpp(0, __float_as_int(x), ctrl, 0xF, 0xF, true))
__device__ __forceinline__ float red8(float v) { v += DPP_F(v, 0xB1); v += DPP_F(v, 0x4E); v += DPP_F(v, 0x141); return v; }

constexpr int BM = 256, BK = 64, HALF = 128, HTB = HALF * BK * 2, NXCD = 8, WGM = 8;
__device__ __forceinline__ int lds_byte(int r, int c) { const int st = (r >> 4) * 2 + (c >> 5), rr = r & 15, cc = c & 31, ob = rr * 64 + cc * 2; return st * 1024 + (ob ^ (((ob >> 9) & 1) << 5)); }
__device__ __forceinline__ void stage_rc(int b, int& R, int& C) { const int st = b / 1024, sb = b % 1024, swz = sb ^ (((sb >> 9) & 1) << 5); R = (st >> 1) * 16 + swz / 64; C = (st & 1) * 32 + (swz % 64) / 2; }
struct Unit { int pm, pn, w; };
struct Gemm { const bf16_t *A, *Bt; int lda, ldb, K;
    __device__ __forceinline__ const char* a(int w) const { return (const char*)A + (w == 1 ? C_RKV * 2 : (w == 2 ? C_SGU * 2 : 0)); }
    __device__ __forceinline__ const char* b(int w) const { return (const char*)Bt + (size_t)w * (1024 * 512 * 2); } };
struct SchedStd {
    int nM, nN, nwg, G, c, skip;
    __device__ void init(int nM_, int nN_, int skip_) { nM = nM_; nN = nN_; nwg = nM * nN; G = gridDim.x; c = lbid(); skip = skip_; }
    __device__ bool next(int i, Unit& u) const {
        const long L = (long)i * G + c; if (L >= nwg) return false;
        int wgid = (int)L; { const int q = nwg / NXCD, r = nwg % NXCD, xcd = wgid % NXCD, off = wgid / NXCD; wgid = (xcd < r ? xcd * (q + 1) : r * (q + 1) + (xcd - r) * q) + off; }
        const int nig = WGM * nN, gid = wgid / nig, fm = gid * WGM, gsz = (nM - fm) < WGM ? (nM - fm) : WGM;
        u.pm = fm + ((wgid % nig) % gsz); u.pn = (wgid % nig) / gsz; u.w = 0;
        if (skip && u.pm >= 64) u.pm += 4;
        return true;
    }
};
struct SchedMerge {
    int ntile, G, c;
    __device__ void init(int ntile_) { ntile = ntile_; G = gridDim.x; c = lbid(); }
    __device__ bool next(int i, Unit& u) const { const int ti = (i / 3) * G + c; if (ti >= ntile) return false; u.pm = ti >> 2; u.pn = ti & 3; u.w = i % 3; return true; }
};

template <class Epi, class Sched>
__device__ __forceinline__ void gemm_phase(LAS unsigned char* lds, const Gemm g, const Sched& S, const Epi& E) {
    const int tid = ltid(), wid = __builtin_amdgcn_readfirstlane(tid >> 6), lane = tid & 63, wr = wid >> 2, wc = wid & 3, fr = lane & 15, fq = lane >> 4;
    const int K = g.K, nt = K / BK;
    unsigned voffA[2], voffB[2];
#pragma unroll
    for (int i = 0; i < 2; ++i) { int R, C; stage_rc(tid * 16 + i * 8192, R, C); voffA[i] = (unsigned)(R * g.lda + C) * 2u; voffB[i] = (unsigned)(R * g.ldb + C) * 2u; }
    const size_t kstep = (size_t)(BK * 2);
    const size_t hstepA = (size_t)HALF * g.lda * 2, hstepB = (size_t)HALF * g.ldb * 2;
    const unsigned ldsw = (unsigned)wid * 1024u;
    const int aoff = lds_byte(wr * 64 + fr, fq * 8), boff = lds_byte(wc * 32 + fr, fq * 8);
#define PG8_SA(b, h) (((b) * 2 + (h)) * HTB)
#define PG8_SB(b, h) ((4 + (b) * 2 + (h)) * HTB)
#define PG8_STAGE(bufoff, gbase, voff) do { _Pragma("unroll") for (int _i = 0; _i < 2; ++_i) \
        __builtin_amdgcn_global_load_lds((const unsigned*)((const char*)(gbase) + (voff)[_i]), (LAS unsigned*)(lds + (bufoff) + ldsw + _i * 8192), 16, 0, 0); } while (0)
#define PG8_LDA(dst, b, h) do { _Pragma("unroll") for (int m = 0; m < 4; ++m) _Pragma("unroll") for (int k = 0; k < 2; ++k) dst[m][k] = *(const LAS bf16x8*)(lds + PG8_SA(b, h) + aoff + m * 2048 + k * 1024); } while (0)
#define PG8_LDB(dst, b, h) do { _Pragma("unroll") for (int n = 0; n < 2; ++n) _Pragma("unroll") for (int k = 0; k < 2; ++k) dst[n][k] = *(const LAS bf16x8*)(lds + PG8_SB(b, h) + boff + n * 2048 + k * 1024); } while (0)
#define PG8_MMA(ai, bj, At, Bt) do { __builtin_amdgcn_s_setprio(1); _Pragma("unroll") for (int m = 0; m < 4; ++m) _Pragma("unroll") for (int n = 0; n < 2; ++n) _Pragma("unroll") for (int k = 0; k < 2; ++k) \
        acc[ai][bj][m][n] = __builtin_amdgcn_mfma_f32_16x16x32_bf16(Bt[n][k], At[m][k], acc[ai][bj][m][n], 0, 0, 0); __builtin_amdgcn_s_setprio(0); } while (0)
#define PG8_WAIT_V(n) asm volatile("s_waitcnt vmcnt(" #n ")" ::: "memory")
#define PG8_WAIT_L(n) asm volatile("s_waitcnt lgkmcnt(" #n ")" ::: "memory")
#define PG8_BAR __builtin_amdgcn_s_barrier()
#define PG8_SCHED __builtin_amdgcn_sched_barrier(0)
    Unit cur, nxt; int ui = 0;
    if (!S.next(0, cur)) return;
    f32x4 acc[2][2][4][2]; f32x4 zacc = zf4();
#pragma unroll
    for (int a = 0; a < 2; ++a)
#pragma unroll
        for (int b = 0; b < 2; ++b)
#pragma unroll
            for (int m = 0; m < 4; ++m)
#pragma unroll
                for (int n = 0; n < 2; ++n) acc[a][b][m][n] = zacc;
    bf16x8 At[4][2], B0[2][2], B1[2][2];
    const char* cA = g.a(cur.w) + (size_t)cur.pm * 2 * hstepA; const char* cB = g.b(cur.w) + (size_t)cur.pn * 2 * hstepB;
    PG8_STAGE(PG8_SB(0, 0), cB, voffB); PG8_STAGE(PG8_SA(0, 0), cA, voffA); PG8_STAGE(PG8_SB(0, 1), cB + hstepB, voffB); PG8_STAGE(PG8_SA(0, 1), cA + hstepA, voffA);
    if (wr == 1) PG8_BAR;
    PG8_WAIT_V(4); PG8_BAR;
    PG8_STAGE(PG8_SB(1, 0), cB + kstep, voffB); PG8_STAGE(PG8_SA(1, 0), cA + kstep, voffA); PG8_STAGE(PG8_SB(1, 1), cB + hstepB + kstep, voffB);
    PG8_WAIT_V(6); PG8_BAR;
    for (;;) {
        const bool has_next = S.next(ui + 1, nxt);
        const char* nA = has_next ? g.a(nxt.w) + (size_t)nxt.pm * 2 * hstepA : cA; const char* nB = has_next ? g.b(nxt.w) + (size_t)nxt.pn * 2 * hstepB : cB;
        for (int t = 0; t < nt; t += 2) {
            const bool last = (t == nt - 2);
            const char* a1 = cA + (size_t)(t + 1) * kstep;
            const char* a2 = last ? nA : cA + (size_t)(t + 2) * kstep; const char* b2 = last ? nB : cB + (size_t)(t + 2) * kstep;
            const char* a3 = a2 + kstep; const char* b3 = b2 + kstep;
            PG8_LDB(B0, 0, 0); PG8_SCHED; PG8_LDA(At, 0, 0); PG8_STAGE(PG8_SA(1, 1), a1 + hstepA, voffA);
            PG8_WAIT_L(8); PG8_BAR; PG8_WAIT_L(0); PG8_MMA(0, 0, At, B0); PG8_BAR; PG8_SCHED;
            PG8_LDB(B1, 0, 1); PG8_STAGE(PG8_SB(0, 0), b2, voffB);
            PG8_BAR; PG8_WAIT_L(0); PG8_MMA(0, 1, At, B1); PG8_BAR;
            PG8_LDA(At, 0, 1); PG8_STAGE(PG8_SA(0, 0), a2, voffA);
            PG8_BAR; PG8_WAIT_L(0); PG8_MMA(1, 0, At, B0); PG8_BAR; PG8_SCHED;
            PG8_STAGE(PG8_SB(0, 1), b2 + hstepB, voffB);
            PG8_WAIT_V(6); PG8_BAR; PG8_MMA(1, 1, At, B1); PG8_BAR;
            PG8_LDB(B0, 1, 0); PG8_SCHED; PG8_LDA(At, 1, 0); PG8_STAGE(PG8_SA(0, 1), a2 + hstepA, voffA);
            PG8_WAIT_L(8); PG8_BAR; PG8_WAIT_L(0); PG8_MMA(0, 0, At, B0); PG8_BAR; PG8_SCHED;
            PG8_LDB(B1, 1, 1); PG8_STAGE(PG8_SB(1, 0), b3, voffB);
            PG8_BAR; PG8_WAIT_L(0); PG8_MMA(0, 1, At, B1); PG8_BAR;
            PG8_LDA(At, 1, 1); PG8_STAGE(PG8_SA(1, 0), a3, voffA);
            PG8_BAR; PG8_WAIT_L(0); PG8_MMA(1, 0, At, B0); PG8_BAR; PG8_SCHED;
            PG8_STAGE(PG8_SB(1, 1), b3 + hstepB, voffB);
            PG8_WAIT_V(6); PG8_BAR; PG8_MMA(1, 1, At, B1); PG8_BAR;
        }
        E(acc, cur, wr, wc, fr, fq);
        if (!has_next) break;
        zacc = zf4();
#pragma unroll
        for (int a = 0; a < 2; ++a)
#pragma unroll
            for (int b = 0; b < 2; ++b)
#pragma unroll
                for (int m = 0; m < 4; ++m)
#pragma unroll
                    for (int n = 0; n < 2; ++n) acc[a][b][m][n] = zacc;
        cur = nxt; cA = nA; cB = nB; ++ui;
    }
    PG8_WAIT_V(0);
    if (wr == 0) PG8_BAR;
    PG8_BAR;
}

#define EPI_LOOP_ROWS for (int ai = 0; ai < 2; ++ai) for (int m = 0; m < 4; ++m, __builtin_amdgcn_sched_barrier(0))
#define EPI_LOOP_COLS for (int bj = 0; bj < 2; ++bj) for (int n = 0; n < 2; ++n)
__device__ __forceinline__ void st_bf4(bf16_t* p, f32x4 v) { uint2 o; o.x = pk2(v[0], v[1]); o.y = pk2(v[2], v[3]); *(uint2*)p = o; }

struct EpiIn {
    bf16_t *qkv, *rw, *sg, *hd;
    __device__ __forceinline__ void operator()(const f32x4 (&acc)[2][2][4][2], const Unit& u, int wr, int wc, int fr, int fq) const {
        bf16_t* base; int ld, c0;
        if (u.pn < 3) { base = qkv; ld = 768; c0 = u.pn * 256; } else if (u.pn < 10) { base = rw; ld = 1792; c0 = (u.pn - 3) * 256; }
        else if (u.pn < 14) { base = sg; ld = 1024; c0 = (u.pn - 10) * 256; } else { base = hd; ld = 32; c0 = 0; }
        const bool hdt = u.pn >= 14;
#pragma unroll
        EPI_LOOP_ROWS { const int row = u.pm * 256 + ai * 128 + wr * 64 + m * 16 + fr;
#pragma unroll
            EPI_LOOP_COLS { const int col = bj * 128 + wc * 32 + n * 16 + fq * 4; if (hdt && (bj != 0 || wc != 0)) continue; st_bf4(base + (size_t)row * ld + c0 + col, acc[ai][bj][m][n]); } }
    }
};
struct EpiPlain {
    bf16_t* o; int ld; int act;
    __device__ __forceinline__ void operator()(const f32x4 (&acc)[2][2][4][2], const Unit& u, int wr, int wc, int fr, int fq) const {
#pragma unroll
        EPI_LOOP_ROWS { const int row = u.pm * 256 + ai * 128 + wr * 64 + m * 16 + fr;
#pragma unroll
            EPI_LOOP_COLS { const int col = u.pn * 256 + bj * 128 + wc * 32 + n * 16 + fq * 4; f32x4 v = acc[ai][bj][m][n];
                if (act) { v[0] = sigm(v[0]); v[1] = sigm(v[1]); v[2] = sigm(v[2]); v[3] = sigm(v[3]); }
                st_bf4(o + (size_t)row * ld + col, v); } }
    }
};
struct EpiAsum {
    bf16_t* asum; const float* a0;
    __device__ __forceinline__ void operator()(const f32x4 (&acc)[2][2][4][2], const Unit& u, int wr, int wc, int fr, int fq) const {
#pragma unroll
        EPI_LOOP_ROWS { const int row = u.pm * 256 + ai * 128 + wr * 64 + m * 16 + fr;
#pragma unroll
            for (int n = 0; n < 2; ++n) { const int col = u.pn * 128 + wc * 32 + n * 16 + fq * 4; f32x4 v;
#pragma unroll
                for (int e = 0; e < 4; ++e) v[e] = sigm(a0[col + e] + acc[ai][0][m][n][e]) + sigm(a0[512 + col + e] + acc[ai][1][m][n][e]);
                st_bf4(asum + (size_t)row * 512 + col, v); } }
    }
};
struct EpiMerge {
    const bf16_t* gate; bf16_t* M; int row0;
    __device__ __forceinline__ void operator()(const f32x4 (&acc)[2][2][4][2], const Unit& u, int wr, int wc, int fr, int fq) const {
#pragma unroll
        EPI_LOOP_ROWS { const int row = u.pm * 256 + ai * 128 + wr * 64 + m * 16 + fr;
#pragma unroll
            EPI_LOOP_COLS { const int col = u.pn * 256 + bj * 128 + wc * 32 + n * 16 + fq * 4;
                const bf16x4 gt = *(const bf16x4*)(gate + (size_t)row * 3072 + u.w * 1024 + col);
                bf16_t* mp = M + (size_t)(row0 + row) * 1024 + col; f32x4 v;
#pragma unroll
                for (int e = 0; e < 4; ++e) v[e] = bfs(gt[e]) * acc[ai][bj][m][n][e];
                if (u.w != 0) { const bf16x4 old = *(const bf16x4*)mp;
#pragma unroll
                    for (int e = 0; e < 4; ++e) v[e] += bfs(old[e]); }
                st_bf4(mp, v); } }
    }
};
struct EpiRes {
    const float* gmod;
    const float *xin, *cin; float *xo, *co; int readInput;
    __device__ __forceinline__ void operator()(const f32x4 (&acc)[2][2][4][2], const Unit& u, int wr, int wc, int fr, int fq) const {
#pragma unroll
        EPI_LOOP_ROWS { const int row = u.pm * 256 + ai * 128 + wr * 64 + m * 16 + fr; int b, t; bool ic; rowinfo(row, b, t, ic);
            const size_t idx = ic ? ((size_t)(b * 256 + t) * 1024) : ((size_t)(b * 4096 + t) * 1024);
            const float* src = readInput ? (ic ? cin : xin) : (ic ? co : xo); float* dst = ic ? co : xo;
            const float* gm = gmod + (ic ? 8 : b) * 6144;
#pragma unroll
            EPI_LOOP_COLS { const int col = u.pn * 256 + bj * 128 + wc * 32 + n * 16 + fq * 4;
                const f32x4 r = *(const f32x4*)(src + idx + col), gg = *(const f32x4*)(gm + col);
                *(f32x4*)(dst + idx + col) = r + gg * acc[ai][bj][m][n]; } }
    }
};
struct EpiSwi {
    bf16_t* U;
    __device__ __forceinline__ void operator()(const f32x4 (&acc)[2][2][4][2], const Unit& u, int wr, int wc, int fr, int fq) const {
#pragma unroll
        EPI_LOOP_ROWS { const int row = u.pm * 256 + ai * 128 + wr * 64 + m * 16 + fr;
#pragma unroll
            for (int n = 0; n < 2; ++n) { const int col = u.pn * 128 + wc * 32 + n * 16 + fq * 4; f32x4 v;
#pragma unroll
                for (int e = 0; e < 4; ++e) { const float a = acc[ai][0][m][n][e]; v[e] = a * sigm(a) * acc[ai][1][m][n][e]; }
                st_bf4(U + (size_t)row * FF + col, v); } }
    }
};

__device__ __forceinline__ void tconv(const float* src, int lds_, int K, int N, bf16_t* dst, int ldd, int mode, int& jobbase) {
    float* tile = (float*)smem;
    const int nkt = K >> 6, nnt = (N + 63) >> 6, njobs = nkt * nnt, G = gridDim.x;
    const int first = (((int)lbid() - jobbase % G) + G) % G;
    for (int j = first; j < njobs; j += G) {
        const int kt = j % nkt, ntile = j / nkt, k0 = kt << 6, n0 = ntile << 6;
        __syncthreads();
        for (int e = 0; e < 8; ++e) { const int k = e * 8 + (ltid() >> 6), n = ltid() & 63; tile[k * 65 + n] = (n0 + n < N) ? src[(size_t)(k0 + k) * lds_ + n0 + n] : 0.f; }
        __syncthreads();
        for (int e = 0; e < 8; ++e) { const int n = e * 8 + (ltid() >> 6), k = ltid() & 63, ng = n0 + n;
            if (ng < N) { const int row = mode == 0 ? ng : ((ng >> 7) * 256 + (ng & 127) + (mode == 2 ? 128 : 0)); dst[(size_t)row * ldd + k0 + k] = f2bf(tile[k * 65 + n]); } }
    }
    jobbase += njobs;
    __syncthreads();
}
__device__ __forceinline__ void zfill(void* ptr, size_t bytes) {
    uint4* q = (uint4*)ptr; const size_t n = bytes >> 4; unsigned z0 = 0; asm volatile("" : "+v"(z0)); const uint4 z = {z0, z0, z0, z0};
    for (size_t i = (size_t)lbid() * 512 + ltid(); i < n; i += (size_t)gridDim.x * 512) q[i] = z;
}
__device__ __forceinline__ void phase_W(PREF p, int l) {
    unsigned char* ws = p.ws; int jb = 0;
    bf16_t* win1 = (bf16_t*)(ws + OFF_WIN1);
    if (l == 1) zfill(win1 + (size_t)(3584 + 32) * 1024, (size_t)224 * 1024 * 2);
    {
        bf16_t* wgl = (bf16_t*)(ws + OFF_WGL);
        for (int i = lbid() * 512 + ltid(); i < 1536 * 256; i += gridDim.x * 512) { const int r = i >> 8, k = i & 255; const bool wr_ = r < 512 ? (k >= 128) : (k >= 64 && k < 128); if (!wr_) wgl[i] = 0; }
    }
    tconv(p.w_in + (size_t)l * 1024 * 6656, 6656, 1024, 3584, win1, 1024, 0, jb);
    if (l == 1) tconv(p.vres_down, 32, 1024, 32, win1 + (size_t)3584 * 1024, 1024, 0, jb);
    tconv(p.w_in + (size_t)l * 1024 * 6656 + 3584, 6656, 1024, 3072, (bf16_t*)(ws + OFF_WGATE), 1024, 0, jb);
    tconv(p.w_o_attn + (size_t)l * 512 * 1024, 1024, 512, 1024, (bf16_t*)(ws + OFF_WO3), 512, 0, jb);
    tconv(p.w_o_rwkv + (size_t)l * 512 * 1024, 1024, 512, 1024, (bf16_t*)(ws + OFF_WO3) + 1024 * 512, 512, 0, jb);
    tconv(p.w_o_sgu + (size_t)l * 512 * 1024, 1024, 512, 1024, (bf16_t*)(ws + OFF_WO3) + 2 * 1024 * 512, 512, 0, jb);
    tconv(p.w_out + (size_t)l * 1024 * 1024, 1024, 1024, 1024, (bf16_t*)(ws + OFF_WOUT), 1024, 0, jb);
    tconv(p.ffn_w1 + (size_t)l * 1024 * FF, FF, 1024, FF, (bf16_t*)(ws + OFF_W13), 1024, 1, jb);
    tconv(p.ffn_w3 + (size_t)l * 1024 * FF, FF, 1024, FF, (bf16_t*)(ws + OFF_W13), 1024, 2, jb);
    tconv(p.ffn_w2 + (size_t)l * FF * 1024, 1024, FF, 1024, (bf16_t*)(ws + OFF_W2), FF, 0, jb);
    tconv(p.rwkv_g_up + (size_t)l * 128 * 512, 512, 128, 512, (bf16_t*)(ws + OFF_WGL) + 128, 256, 0, jb);
    tconv(p.rwkv_a_up + (size_t)(l * 2 + 0) * 64 * 512, 512, 64, 512, (bf16_t*)(ws + OFF_WGL) + 512 * 256 + 64, 256, 1, jb);
    tconv(p.rwkv_a_up + (size_t)(l * 2 + 1) * 64 * 512, 512, 64, 512, (bf16_t*)(ws + OFF_WGL) + 512 * 256 + 64, 256, 2, jb);
    for (int d = 0; d < 2; ++d) {
        tconv(p.rwkv_w_up + (size_t)(l * 2 + d) * 64 * 512, 512, 64, 512, (bf16_t*)(ws + OFF_WWA) + (size_t)(d * 2 + 0) * 512 * 64, 64, 0, jb);
        tconv(p.rwkv_a_up + (size_t)(l * 2 + d) * 64 * 512, 512, 64, 512, (bf16_t*)(ws + OFF_WWA) + (size_t)(d * 2 + 1) * 512 * 64, 64, 0, jb);
    }
    {   bf16_t* wsg = (bf16_t*)(ws + OFF_WSGU); const float* s = p.sgu_w + (size_t)l * 65536;
        for (int i = lbid() * 512 + ltid(); i < 65536; i += gridDim.x * 512) wsg[i] = f2bf(s[i]); }
    if (l == 0) {
        float* cs = (float*)(ws + OFF_ROPE);
        for (int i = lbid() * 512 + ltid(); i < 4096 * 32; i += gridDim.x * 512) { const int t = i >> 5, f = i & 31; const float pos = (float)(f < 16 ? (t >> 6) : (t & 63));
            const float inv = exp2f(-(float)(f & 15) * (13.287712379549449f / 16.0f)); const float ang = pos * inv; cs[2 * i] = __cosf(ang); cs[2 * i + 1] = __sinf(ang); }
        float* sc = (float*)smem; float* red = sc + 9 * 1024; float* mod = (float*)(ws + OFF_MOD);
        __syncthreads();
        for (int i = ltid(); i < 9 * 1024; i += 512) { const float v = i < 8192 ? p.c[i] : p.c_ctx[i - 8192]; sc[i] = v * sigm(v); }
        __syncthreads();
        for (int it = lbid(); it < 192; it += gridDim.x) {
            const int ll = it / 96, j0 = (it % 96) * 64, kg = ltid() >> 6, jj = ltid() & 63;
            float a[9];
#pragma unroll
            for (int r = 0; r < 9; ++r) a[r] = 0.f;
            const float* wp = p.w_mod + (size_t)ll * 1024 * 6144 + j0 + jj;
            for (int i = kg * 128; i < kg * 128 + 128; ++i) { const float w = wp[(size_t)i * 6144];
#pragma unroll
                for (int r = 0; r < 9; ++r) a[r] += sc[r * 1024 + i] * w; }
            __syncthreads();
#pragma unroll
            for (int r = 0; r < 9; ++r) red[(kg * 9 + r) * 64 + jj] = a[r];
            __syncthreads();
            for (int idx = ltid(); idx < 576; idx += 512) { const int r = idx >> 6, j2 = idx & 63; float s = 0.f; for (int k2 = 0; k2 < 8; ++k2) s += red[(k2 * 9 + r) * 64 + j2];
                mod[(size_t)(ll * 9 + r) * 6144 + j0 + j2] = s + p.b_mod[(size_t)ll * 6144 + j0 + j2]; }
        }
        __syncthreads();
    }
}

__device__ __forceinline__ void phase_norm(PREF p, int l, int which, int r0, int nrows, bf16_t* dst, bool readInput, bool skipctx) {
    const int lane = ltid() & 63, gw = lbid() * 8 + (ltid() >> 6);
    const float* mod = (const float*)(p.ws + OFF_MOD) + (size_t)l * 9 * 6144; const float* xsc = (const float*)(p.ws + OFF_XSC);
    const float* gain = (which ? p.norm_ffn : p.norm_mix) + l * 1024;
    for (int ri = gw; ri < nrows; ri += gridDim.x * 8) {
        const int r = r0 + ri; int b, t; bool ic; rowinfo(r, b, t, ic);
        if (skipctx && ic) continue;
        const float* src = ic ? ((readInput ? p.ctx : xsc) + (size_t)(b * 256 + t) * 1024) : ((readInput ? p.x : p.out) + (size_t)(b * 4096 + t) * 1024);
        f32x4 v[4]; float ss = 0.f;
#pragma unroll
        for (int e = 0; e < 4; ++e) { v[e] = *(const f32x4*)(src + e * 256 + lane * 4); ss += v[e][0] * v[e][0] + v[e][1] * v[e][1] + v[e][2] * v[e][2] + v[e][3] * v[e][3]; }
        ss = wsum(ss); const float rstd = rsqrtf(ss * (1.0f / 1024.0f) + 1e-6f);
        const float* mr = mod + (ic ? 8 : b) * 6144 + (which ? 3 : 0) * 1024;
#pragma unroll
        for (int e = 0; e < 4; ++e) { const int c = e * 256 + lane * 4; const f32x4 gn = *(const f32x4*)(gain + c), sh = *(const f32x4*)(mr + c), sc = *(const f32x4*)(mr + 1024 + c);
            f32x4 h = v[e] * rstd * gn * (sc + 1.0f) + sh; st_bf4(dst + (size_t)ri * 1024 + c, h); }
    }
}

__device__ __forceinline__ void phase_prep(PREF p, int l, int hf) {
    unsigned char* ws = p.ws; const int tid = ltid(), lane = tid & 63, wave = tid >> 6;
    const bf16_t* QKVh = (const bf16_t*)(ws + OFF_B + B_QKV); const bf16_t* RWh = (const bf16_t*)(ws + OFF_B + B_RW);
    const bf16_t* SGh = (const bf16_t*)(ws + OFF_B + B_SG); const bf16_t* HDh = (const bf16_t*)(ws + OFF_B + B_HD);
    bf16_t* BIG = (bf16_t*)(ws + OFF_BIG); bf16_t* AL = (bf16_t*)(ws + OFF_AL); bf16_t* vnT = (bf16_t*)(ws + OFF_VNT);
    bf16_t* vTl = (bf16_t*)(ws + OFF_VT); bf16_t* vTc = vTl + (size_t)8 * 128 * 4096; bf16_t* V0 = (bf16_t*)(ws + OFF_V0); float* RINV = (float*)(ws + OFF_RINV);
    const float* cs = (const float*)(ws + OFF_ROPE);
    bf16_t* lt = (bf16_t*)smem;
    const int ch = tid * 4; float cw[3][4] = {{0}}, kkw[4] = {0, 0, 0, 0}, vb[4] = {0, 0, 0, 0};
    if (tid < 448) { for (int i = 0; i < 3; ++i) for (int e = 0; e < 4; ++e) cw[i][e] = p.rwkv_conv[(size_t)(l * 3 + i) * 1792 + ch + e]; }
    if (tid >= 128 && tid < 256) for (int e = 0; e < 4; ++e) kkw[e] = p.rwkv_k_k[l * 512 + ch - 512 + e];
    const bool isv = tid >= 256 && tid < 384;
    float* upl = (float*)(smem + 49152);
    if (l == 1) { for (int i = tid; i < 32 * 512; i += 512) upl[i] = p.vres_up[i]; if (isv) for (int e = 0; e < 4; ++e) vb[e] = p.vres_b[ch - 1024 + e]; }
    __syncthreads();
    for (int strip = lbid(); strip < HROWS / 32; strip += gridDim.x) {
        const int rr0 = strip * 32, r0 = hf * HROWS + rr0; int b, t0; bool ic; rowinfo(r0, b, t0, ic);
        const int T = ic ? 256 : 4096;
        for (int i = 0; i < 4; ++i) {
            const int rr = rr0 + wave * 4 + i, r = hf * HROWS + rr, t = t0 + wave * 4 + i;
            const int g = lane & 7;
#pragma unroll
            for (int pass = 0; pass < 2; ++pass) {
                const int hh = pass == 0 ? (lane >> 3) : ((lane >> 3) & 1);
                const int scol = pass == 0 ? hh * 64 + g * 8 : 512 + hh * 64 + g * 8;
                const bf16x8 raw = *(const bf16x8*)(QKVh + (size_t)rr * 768 + scol);
                const float* gn = (pass == 0 ? p.q_gain : p.k_gain) + l * 64 + g * 8;
                float x[8], ss = 0.f;
#pragma unroll
                for (int e = 0; e < 8; ++e) { x[e] = bfs(raw[e]); ss += x[e] * x[e]; }
                ss += __shfl_xor(ss, 1); ss += __shfl_xor(ss, 2); ss += __shfl_xor(ss, 4);
                const float rstd = rsqrtf(ss * (1.0f / 64.0f) + 1e-6f);
#pragma unroll
                for (int e = 0; e < 8; ++e) x[e] = x[e] * rstd * gn[e];
                float y[8];
#pragma unroll
                for (int e = 0; e < 8; ++e) { const float o = __shfl_xor(x[e], 4);
                    if (ic) y[e] = x[e];
                    else { const int fi = (g & 3) * 8 + e; const float co = cs[(size_t)(t * 32 + fi) * 2], si = cs[(size_t)(t * 32 + fi) * 2 + 1];
                        y[e] = (g < 4) ? (x[e] * co - o * si) : (o * si + x[e] * co); } }
                const float scl = pass == 0 ? 0.125f : 1.0f;
                uint4 st; st.x = pk2(y[0] * scl, y[1] * scl); st.y = pk2(y[2] * scl, y[3] * scl); st.z = pk2(y[4] * scl, y[5] * scl); st.w = pk2(y[6] * scl, y[7] * scl);
                if (pass == 0 || lane < 16) *(uint4*)(BIG + (size_t)r * LDB + scol) = st;
            }
        }
        __syncthreads();
        { const int row = tid >> 4, cq = tid & 15; *(uint4*)(lt + row * 136 + cq * 8) = *(const uint4*)(QKVh + (size_t)(rr0 + row) * 768 + 640 + cq * 8); }
        __syncthreads();
        { const int c = tid >> 2, tq = tid & 3; bf16_t tmp[8];
#pragma unroll
            for (int e = 0; e < 8; ++e) tmp[e] = lt[(tq * 8 + e) * 136 + c];
            uint4 st; st.x = tmp[0] | ((unsigned)tmp[1] << 16); st.y = tmp[2] | ((unsigned)tmp[3] << 16); st.z = tmp[4] | ((unsigned)tmp[5] << 16); st.w = tmp[6] | ((unsigned)tmp[7] << 16);
            bf16_t* dstp = ic ? (vTc + (size_t)(b * 128 + c) * 256 + t0 + tq * 8) : (vTl + (size_t)(b * 128 + c) * 4096 + t0 + tq * 8);
            *(uint4*)dstp = st; }
        __syncthreads();
        for (int i = 0; i < 4; ++i) {
            const int rl = wave * 4 + i, rr = rr0 + rl, r = hf * HROWS + rr;
            const bf16x8 ur = *(const bf16x8*)(SGh + (size_t)rr * 1024 + lane * 8), vr = *(const bf16x8*)(SGh + (size_t)rr * 1024 + 512 + lane * 8);
            float u[8], v[8], s1 = 0.f;
#pragma unroll
            for (int e = 0; e < 8; ++e) { u[e] = gelu_t(bfs(ur[e])); v[e] = gelu_t(bfs(vr[e])); s1 += v[e]; }
            uint4 st; st.x = pk2(u[0], u[1]); st.y = pk2(u[2], u[3]); st.z = pk2(u[4], u[5]); st.w = pk2(u[6], u[7]);
            *(uint4*)(BIG + (size_t)r * LDB + C_SGU + lane * 8) = st;
            const float mu = wsum(s1) * (1.0f / 512.0f); float s2 = 0.f;
#pragma unroll
            for (int e = 0; e < 8; ++e) { v[e] -= mu; s2 += v[e] * v[e]; }
            const float rstd = rsqrtf(wsum(s2) * (1.0f / 512.0f) + 1e-6f);
            const float* lw = p.sgu_ln_w + l * 512 + lane * 8; const float* lb = p.sgu_ln_b + l * 512 + lane * 8;
#pragma unroll
            for (int e = 0; e < 8; ++e) lt[rl * 520 + lane * 8 + e] = f2bf(v[e] * rstd * lw[e] + lb[e]);
        }
        __syncthreads();
        { const int c = tid;
#pragma unroll
            for (int q4 = 0; q4 < 4; ++q4) { bf16_t tmp[8];
#pragma unroll
                for (int e = 0; e < 8; ++e) tmp[e] = lt[(q4 * 8 + e) * 520 + c];
                uint4 st; st.x = tmp[0] | ((unsigned)tmp[1] << 16); st.y = tmp[2] | ((unsigned)tmp[3] << 16); st.z = tmp[4] | ((unsigned)tmp[5] << 16); st.w = tmp[6] | ((unsigned)tmp[7] << 16);
                *(uint4*)(vnT + (size_t)c * NROW + r0 + q4 * 8) = st; } }
        __syncthreads();
        if (tid < 448) {
            float pv[4], cv[4], nv[4];
            { const bool ok = t0 > 0; const bf16x4 a = ok ? *(const bf16x4*)(RWh + (size_t)(rr0 - 1) * 1792 + ch) : (bf16x4){0, 0, 0, 0};
              const bf16x4 c2 = *(const bf16x4*)(RWh + (size_t)rr0 * 1792 + ch);
#pragma unroll
              for (int e = 0; e < 4; ++e) { pv[e] = bfs(a[e]); cv[e] = bfs(c2[e]); } }
            for (int i = 0; i < 32; ++i) {
                const int rr = rr0 + i, r = hf * HROWS + rr, t = t0 + i;
                { const bool ok = t + 1 < T; const bf16x4 a = ok ? *(const bf16x4*)(RWh + (size_t)(rr + 1) * 1792 + ch) : (bf16x4){0, 0, 0, 0};
#pragma unroll
                  for (int e = 0; e < 4; ++e) nv[e] = bfs(a[e]); }
                float o[4];
#pragma unroll
                for (int e = 0; e < 4; ++e) o[e] = pv[e] * cw[0][e] + cv[e] * cw[1][e] + nv[e] * cw[2][e];
                if (tid < 128) { uint2 st; st.x = pk2(o[0], o[1]); st.y = pk2(o[2], o[3]); *(uint2*)(BIG + (size_t)r * LDB + C_RKV + ch) = st; }
                else if (tid < 256) {
                    uint2 st; st.x = pk2(o[0], o[1]); st.y = pk2(o[2], o[3]); *(uint2*)(BIG + (size_t)r * LDB + C_RKV + ch) = st;
                    float s = 0.f;
#pragma unroll
                    for (int e = 0; e < 4; ++e) { const float kq = o[e] * kkw[e]; s += kq * kq; }
                    s += __shfl_xor(s, 1); s += __shfl_xor(s, 2); s += __shfl_xor(s, 4); s += __shfl_xor(s, 8);
                    if ((tid & 15) == 0) RINV[(size_t)r * 8 + ((tid - 128) >> 4)] = rsqrtf(s + 1e-12f);
                } else if (tid < 384) {
                    if (l == 0) { uint2 st; st.x = pk2(o[0], o[1]); st.y = pk2(o[2], o[3]); *(uint2*)(V0 + (size_t)r * 512 + ch - 1024) = st; }
                    else {
                        float z[4] = {vb[0], vb[1], vb[2], vb[3]};
#pragma unroll
                        for (int jq = 0; jq < 4; ++jq) { const bf16x8 hd = *(const bf16x8*)(HDh + (size_t)rr * 32 + jq * 8);
#pragma unroll
                            for (int j = 0; j < 8; ++j) { const float hv = bfs(hd[j]); const f32x4 uu = *(const f32x4*)(upl + (jq * 8 + j) * 512 + ch - 1024);
#pragma unroll
                                for (int e = 0; e < 4; ++e) z[e] += hv * uu[e]; } }
                        const bf16x4 vf = *(const bf16x4*)(V0 + (size_t)r * 512 + ch - 1024);
#pragma unroll
                        for (int e = 0; e < 4; ++e) o[e] = o[e] + (bfs(vf[e]) - o[e]) * sigm(z[e]);
                    }
                    uint2 st; st.x = pk2(o[0], o[1]); st.y = pk2(o[2], o[3]); *(uint2*)(BIG + (size_t)r * LDB + C_RKV + ch) = st;
                } else {
                    const int ac = ch - 1536;
#pragma unroll
                    for (int e = 0; e < 4; ++e) { if (ac < 64) o[e] = 1.0f - 2.0f / (1.0f + __expf(2.0f * o[e])); else if (ac >= 128) o[e] = sigm(o[e]); }
                    uint2 st; st.x = pk2(o[0], o[1]); st.y = pk2(o[2], o[3]); *(uint2*)(AL + (size_t)r * 256 + ac) = st;
                }
#pragma unroll
                for (int e = 0; e < 4; ++e) { pv[e] = cv[e]; cv[e] = nv[e]; }
            }
        }
        __syncthreads();
    }
}

__device__ __forceinline__ void scan_block(PREF p, int l) {
    unsigned char* ws = p.ws; const int tid = ltid(), lane = tid & 63, wave = tid >> 6;
    const int s = lbid(), d = s >> 6, b = (s >> 3) & 7, h = s & 7;
    const bf16_t* BIG = (const bf16_t*)(ws + OFF_BIG); const bf16_t* AL = (const bf16_t*)(ws + OFF_AL); const float* RINV = (const float*)(ws + OFF_RINV);
    bf16_t* Y = (bf16_t*)(ws + OFF_B + B_Y) + (size_t)d * NROW * 512;
    float* stg = (float*)smem;
    const int NC = 136;
    float S0[8], S1[8];
#pragma unroll
    for (int j = 0; j < 8; ++j) { S0[j] = 0.f; S1[j] = 0.f; }
    const int rp = lane >> 3, kq = lane & 7, v0 = 16 * (wave & 3) + 2 * rp;
    const int lt = tid - 256, lw = (lt >> 6) & 3, c16 = lane & 15, quad = lane >> 4, chn = 16 * lw + c16, chg = h * 64 + chn;
    const int sidx1 = (lt >> 3) & 31, cg8 = lt & 7;
    bf16x8 bw[2], ba[2]; float w0c = 0.f, a0c = 0.f, kkc = 0.f, kac = 0.f, kk8[8];
    {   const bf16_t* wwa = (const bf16_t*)(ws + OFF_WWA);
        for (int ks = 0; ks < 2; ++ks) { bw[ks] = *(const bf16x8*)(wwa + (size_t)((d * 2 + 0) * 512 + chg) * 64 + ks * 32 + quad * 8); ba[ks] = *(const bf16x8*)(wwa + (size_t)((d * 2 + 1) * 512 + chg) * 64 + ks * 32 + quad * 8); }
        w0c = p.rwkv_w0[(l * 2 + d) * 512 + chg]; a0c = p.rwkv_a0[(l * 2 + d) * 512 + chg]; kkc = p.rwkv_k_k[l * 512 + chg]; kac = p.rwkv_k_a[l * 512 + chg];
#pragma unroll
        for (int e = 0; e < 8; ++e) kk8[e] = p.rwkv_k_k[l * 512 + h * 64 + cg8 * 8 + e]; }
    auto load_chunk = [&](int ci, float* buf) {
        const int isl = ci >= 8, i0 = isl ? (ci - 8) * 32 : ci * 32, T = isl ? 4096 : 256, seg = isl ? seg_lat(b) : seg_ctx(b);
        {
            const int i = i0 + sidx1, row = seg + (d ? T - 1 - i : i);
            const bf16_t* rb = BIG + (size_t)row * LDB + C_RKV + h * 64 + cg8 * 8;
            const bf16x8 r8 = *(const bf16x8*)rb, k8 = *(const bf16x8*)(rb + 512), v8 = *(const bf16x8*)(rb + 1024); const float rinv = RINV[(size_t)row * 8 + h];
            float* base = buf + sidx1 * 384 + cg8 * 8; f32x4 t0, t1;
#pragma unroll
            for (int e = 0; e < 4; ++e) { t0[e] = -bfs(k8[e]) * kk8[e] * rinv; t1[e] = -bfs(k8[4 + e]) * kk8[4 + e] * rinv; }
            *(f32x4*)(base) = t0; *(f32x4*)(base + 4) = t1;
#pragma unroll
            for (int e = 0; e < 4; ++e) { t0[e] = bfs(r8[e]); t1[e] = bfs(r8[4 + e]); }
            *(f32x4*)(base + 256) = t0; *(f32x4*)(base + 260) = t1;
#pragma unroll
            for (int e = 0; e < 4; ++e) { t0[e] = bfs(v8[e]); t1[e] = bfs(v8[4 + e]); }
            *(f32x4*)(base + 320) = t0; *(f32x4*)(base + 324) = t1;
        }
#pragma unroll
        for (int m = 0; m < 2; ++m) {
            const int iA = i0 + m * 16 + c16, rowA = seg + (d ? T - 1 - iA : iA);
            f32x4 aw = zf4(), aa = zf4();
#pragma unroll
            for (int ks = 0; ks < 2; ++ks) { const bf16x8 xw = *(const bf16x8*)(AL + (size_t)rowA * 256 + ks * 32 + quad * 8), xa = *(const bf16x8*)(AL + (size_t)rowA * 256 + 64 + ks * 32 + quad * 8);
                aw = __builtin_amdgcn_mfma_f32_16x16x32_bf16(xw, bw[ks], aw, 0, 0, 0); aa = __builtin_amdgcn_mfma_f32_16x16x32_bf16(xa, ba[ks], aa, 0, 0, 0); }
#pragma unroll
            for (int e = 0; e < 4; ++e) { const int si = m * 16 + quad * 4 + e, i = i0 + si, row = seg + (d ? T - 1 - i : i);
                const float kf = bf2f(BIG[(size_t)row * LDB + C_RKV + 512 + chg]), rinv = RINV[(size_t)row * 8 + h];
                const float dec = __expf(-0.6065306597f * sigm(w0c + aw[e])), as = sigm(a0c + aa[e]);
                float* base = buf + si * 384 + chn; base[64] = dec; base[128] = kf * (1.0f + (as - 1.0f) * kac); base[192] = kf * kkc * rinv * as; }
        }
    };
    if (wave >= 4) load_chunk(0, stg);
    __syncthreads();
    for (int ci = 0; ci < NC; ++ci) {
        float* buf = stg + (ci & 1) * (32 * 384);
        if (wave < 4) {
            const int isl = ci >= 8, i0 = isl ? (ci - 8) * 32 : ci * 32, T = isl ? 4096 : 256, seg = isl ? seg_lat(b) : seg_ctx(b);
#pragma unroll 4
            for (int st = 0; st < 32; ++st) {
                const float* base = buf + st * 384 + kq * 8;
                const f32x4 a0 = *(const f32x4*)(base), a1 = *(const f32x4*)(base + 4), w0 = *(const f32x4*)(base + 64), w1 = *(const f32x4*)(base + 68),
                            k0 = *(const f32x4*)(base + 128), k1 = *(const f32x4*)(base + 132), b0 = *(const f32x4*)(base + 192), b1 = *(const f32x4*)(base + 196),
                            r0 = *(const f32x4*)(base + 256), r1 = *(const f32x4*)(base + 260);
                const f32x2 vv = *(const f32x2*)(buf + st * 384 + 320 + v0);
                float sa0 = 0.f, sa1 = 0.f;
#pragma unroll
                for (int j = 0; j < 4; ++j) { sa0 += S0[j] * a0[j] + S0[4 + j] * a1[j]; sa1 += S1[j] * a0[j] + S1[4 + j] * a1[j]; }
                sa0 = red8(sa0); sa1 = red8(sa1);
                float y0 = 0.f, y1 = 0.f;
#pragma unroll
                for (int j = 0; j < 4; ++j) {
                    S0[j] = S0[j] * w0[j] + (sa0 * b0[j] + vv[0] * k0[j]); S0[4 + j] = S0[4 + j] * w1[j] + (sa0 * b1[j] + vv[0] * k1[j]);
                    S1[j] = S1[j] * w0[j] + (sa1 * b0[j] + vv[1] * k0[j]); S1[4 + j] = S1[4 + j] * w1[j] + (sa1 * b1[j] + vv[1] * k1[j]);
                    y0 += S0[j] * r0[j] + S0[4 + j] * r1[j]; y1 += S1[j] * r0[j] + S1[4 + j] * r1[j]; }
                y0 = red8(y0); y1 = red8(y1);
                if (kq == 0) { const int i = i0 + st, row = seg + (d ? T - 1 - i : i); *(unsigned*)(Y + (size_t)row * 512 + h * 64 + v0) = pk2(y0, y1); }
            }
        } else if (ci + 1 < NC) load_chunk(ci + 1, stg + ((ci + 1) & 1) * (32 * 384));
        __syncthreads();
    }
}

__device__ __forceinline__ void attn_item(PREF p, int l, int item) {
    unsigned char* ws = p.ws; const int tid = ltid(), lane = tid & 63, wave = tid >> 6, g = wave >> 1, hq = wave & 1, quad = lane >> 4, c16 = lane & 15;
    bf16_t* BIG = (bf16_t*)(ws + OFF_BIG); const bf16_t* vTl = (const bf16_t*)(ws + OFF_VT); const bf16_t* vTc = vTl + (size_t)8 * 128 * 4096;
    int b, qb = 0, kvh, q0, qrow0; bool latent;
    if (item < 512) { latent = true; b = item >> 6; qb = (item >> 1) & 31; kvh = item & 1; q0 = qb * 128 + 64 * hq; qrow0 = seg_lat(b) + q0; }
    else { const int it2 = item - 512; latent = false; b = it2 >> 2; kvh = (it2 >> 1) & 1; q0 = (it2 & 1) * 128 + 64 * hq; qrow0 = seg_ctx(b) + q0; }
    const int head = kvh * 4 + g; const float sink = p.attn_sink[l * 8 + head];
    const int nblk = latent ? 9 : 4;
    for (int qh = 0; qh < 2; ++qh) {
    const int qr = qrow0 + qh * 32, qq = q0 + qh * 32;
    bf16x8 qf[2][2];
#pragma unroll
    for (int qt = 0; qt < 2; ++qt)
#pragma unroll
        for (int ks = 0; ks < 2; ++ks) qf[qt][ks] = *(const bf16x8*)(BIG + (size_t)(qr + qt * 16 + c16) * LDB + head * 64 + ks * 32 + quad * 8);
    f32x4 o[4][2]; float mx[2], ls[2];
#pragma unroll
    for (int qt = 0; qt < 2; ++qt) { mx[qt] = sink; ls[qt] = quad == 0 ? 1.0f : 0.0f;
#pragma unroll
        for (int dt = 0; dt < 4; ++dt) o[dt][qt] = zf4(); }
    for (int blk = 0; blk < nblk; ++blk) {
        const bool band = latent && blk < 5; int krow0, vstride, kp0 = 0; const bf16_t* vt;
        if (band) { kp0 = qb * 128 - 128 + 64 * (hq + blk); if (kp0 < 0 || kp0 >= 4096) continue; krow0 = seg_lat(b) + kp0; vt = vTl + (size_t)(b * 128 + kvh * 64) * 4096 + kp0; vstride = 4096; }
        else { const int cb = latent ? blk - 5 : blk; krow0 = seg_ctx(b) + 64 * cb; vt = vTc + (size_t)(b * 128 + kvh * 64) * 256 + 64 * cb; vstride = 256; }
        f32x4 s[4][2];
#pragma unroll
        for (int kt = 0; kt < 4; ++kt) { const bf16_t* kp = BIG + (size_t)(krow0 + kt * 16 + c16) * LDB + 512 + kvh * 64 + quad * 8;
            const bf16x8 kf0 = *(const bf16x8*)kp, kf1 = *(const bf16x8*)(kp + 32);
#pragma unroll
            for (int qt = 0; qt < 2; ++qt) { f32x4 a = zf4(); a = __builtin_amdgcn_mfma_f32_16x16x32_bf16(kf0, qf[qt][0], a, 0, 0, 0); a = __builtin_amdgcn_mfma_f32_16x16x32_bf16(kf1, qf[qt][1], a, 0, 0, 0); s[kt][qt] = a; } }
        if (band) {
#pragma unroll
            for (int kt = 0; kt < 4; ++kt)
#pragma unroll
                for (int qt = 0; qt < 2; ++qt)
#pragma unroll
                    for (int e = 0; e < 4; ++e) { const int dl = (kp0 + kt * 16 + quad * 4 + e) - (qq + qt * 16 + c16); if (dl > 128 || dl < -128) s[kt][qt][e] = -1e30f; }
        }
#pragma unroll
        for (int qt = 0; qt < 2; ++qt) {
            float m2 = s[0][qt][0];
#pragma unroll
            for (int kt = 0; kt < 4; ++kt)
#pragma unroll
                for (int e = 0; e < 4; ++e) m2 = fmaxf(m2, s[kt][qt][e]);
            m2 = fmaxf(m2, __shfl_xor(m2, 16)); m2 = fmaxf(m2, __shfl_xor(m2, 32));
            const float mn = fmaxf(mx[qt], m2), al = __expf(mx[qt] - mn); mx[qt] = mn; float lsum = ls[qt] * al;
#pragma unroll
            for (int dt = 0; dt < 4; ++dt) o[dt][qt] *= al;
#pragma unroll
            for (int kt = 0; kt < 4; ++kt)
#pragma unroll
                for (int e = 0; e < 4; ++e) { const float pe = __expf(s[kt][qt][e] - mn); lsum += pe; s[kt][qt][e] = pe; }
            ls[qt] = lsum;
        }
#pragma unroll
        for (int kp2 = 0; kp2 < 2; ++kp2) {
            bf16x8 pb[2];
#pragma unroll
            for (int qt = 0; qt < 2; ++qt)
#pragma unroll
                for (int e = 0; e < 4; ++e) { pb[qt][e] = (short)f2bf(s[2 * kp2][qt][e]); pb[qt][4 + e] = (short)f2bf(s[2 * kp2 + 1][qt][e]); }
#pragma unroll
            for (int dt = 0; dt < 4; ++dt) {
                const bf16_t* vp = vt + (size_t)(dt * 16 + c16) * vstride + (2 * kp2) * 16 + quad * 4;
                const bf16x4 va = *(const bf16x4*)vp, vb = *(const bf16x4*)(vp + 16);
                bf16x8 vf; vf[0] = va[0]; vf[1] = va[1]; vf[2] = va[2]; vf[3] = va[3]; vf[4] = vb[0]; vf[5] = vb[1]; vf[6] = vb[2]; vf[7] = vb[3];
#pragma unroll
                for (int qt = 0; qt < 2; ++qt) o[dt][qt] = __builtin_amdgcn_mfma_f32_16x16x32_bf16(vf, pb[qt], o[dt][qt], 0, 0, 0);
            }
        }
    }
#pragma unroll
    for (int qt = 0; qt < 2; ++qt) {
        float lt = ls[qt]; lt += __shfl_xor(lt, 16); lt += __shfl_xor(lt, 32); const float inv = 1.0f / lt;
#pragma unroll
        for (int dt = 0; dt < 4; ++dt) st_bf4(BIG + (size_t)(qr + qt * 16 + c16) * LDB + head * 64 + dt * 16 + quad * 4, o[dt][qt] * inv);
    }
    }
}

__device__ __forceinline__ void sgu_tile(PREF p, int l, int tile) {
    unsigned char* ws = p.ws; const int tid = ltid(), lane = tid & 63, w = tid >> 6, quad = lane >> 4, c16 = lane & 15;
    const int n = tile >> 2, g = tile & 3, row0 = n * 128;
    bf16_t* BIG = (bf16_t*)(ws + OFF_BIG); const bf16_t* vnT = (const bf16_t*)(ws + OFF_VNT); const bf16_t* wsg = (const bf16_t*)(ws + OFF_WSGU);
    f32x4 acc[8];
#pragma unroll
    for (int i = 0; i < 8; ++i) acc[i] = zf4();
#pragma unroll
    for (int ks = 0; ks < 4; ++ks) {
        const bf16x8 af = *(const bf16x8*)(wsg + (size_t)((g * 128 + 16 * w + c16) * 128) + ks * 32 + quad * 8);
#pragma unroll
        for (int nt = 0; nt < 8; ++nt) { const bf16x8 bf = *(const bf16x8*)(vnT + (size_t)(g * 128 + nt * 16 + c16) * NROW + row0 + ks * 32 + quad * 8);
            acc[nt] = __builtin_amdgcn_mfma_f32_16x16x32_bf16(af, bf, acc[nt], 0, 0, 0); }
    }
#pragma unroll
    for (int e = 0; e < 4; ++e) { const int pl = 16 * w + quad * 4 + e; const float bias = p.sgu_b[l * 512 + g * 128 + pl];
#pragma unroll
        for (int nt = 0; nt < 8; ++nt) { bf16_t* q = BIG + (size_t)(row0 + pl) * LDB + C_SGU + g * 128 + nt * 16 + c16; *q = f2bf(bf2f(*q) * (acc[nt][e] + bias)); } }
}

__device__ __forceinline__ void phase_mix(PREF p, int l) {
    if (lbid() < 128) { scan_block(p, l); return; }
    const int nb = gridDim.x - 128, bid = lbid() - 128; const bool last = l == 1;
    const int nAttn = last ? 512 : 544, nS = 1088;
    for (int it = bid; it < nAttn + nS; it += nb) {
        if (it < nAttn) attn_item(p, l, it);
        else { const int tile = it - nAttn; const int n = tile >> 2; if (last && ((n * 128) % HROWS) >= 16384) continue; sgu_tile(p, l, tile); }
    }
}

__device__ __forceinline__ void phase_post(PREF p, int l) {
    unsigned char* ws = p.ws; const int lane = ltid() & 63, gw = lbid() * 8 + (ltid() >> 6); const bool last = l == 1;
    bf16_t* BIG = (bf16_t*)(ws + OFF_BIG); const bf16_t* Gb = (const bf16_t*)(ws + OFF_B + B_G); const bf16_t* AS = (const bf16_t*)(ws + OFF_B + B_ASUM);
    const bf16_t* Y0 = (const bf16_t*)(ws + OFF_B + B_Y); const bf16_t* Y1 = Y0 + (size_t)NROW * 512;
    const int c = lane * 8;
    float lw[8], lb[8], rk[8], ka[8];
#pragma unroll
    for (int e = 0; e < 8; ++e) { lw[e] = p.rwkv_ln_w[l * 512 + c + e]; lb[e] = p.rwkv_ln_b[l * 512 + c + e]; rk[e] = p.rwkv_r_k[l * 512 + c + e]; ka[e] = p.rwkv_k_a[l * 512 + c + e]; }
    for (int r = gw; r < NROW; r += gridDim.x * 8) {
        if (last && (r % HROWS) >= 16384) continue;
        const bf16x8 y0 = *(const bf16x8*)(Y0 + (size_t)r * 512 + c), y1 = *(const bf16x8*)(Y1 + (size_t)r * 512 + c), gg = *(const bf16x8*)(Gb + (size_t)r * 512 + c), as = *(const bf16x8*)(AS + (size_t)r * 512 + c);
        bf16_t* rb = BIG + (size_t)r * LDB + C_RKV + c;
        const bf16x8 r8 = *(const bf16x8*)rb, k8 = *(const bf16x8*)(rb + 512), v8 = *(const bf16x8*)(rb + 1024);
        float y[8], s1 = 0.f, bo = 0.f;
#pragma unroll
        for (int e = 0; e < 8; ++e) { y[e] = bfs(y0[e]) + bfs(y1[e]); s1 += y[e]; bo += bfs(r8[e]) * bfs(k8[e]) * rk[e] * (2.0f + (bfs(as[e]) - 2.0f) * ka[e]); }
        s1 += __shfl_xor(s1, 1); s1 += __shfl_xor(s1, 2); s1 += __shfl_xor(s1, 4);
        bo += __shfl_xor(bo, 1); bo += __shfl_xor(bo, 2); bo += __shfl_xor(bo, 4);
        const float mu = s1 * (1.0f / 64.0f); float s2 = 0.f;
#pragma unroll
        for (int e = 0; e < 8; ++e) { y[e] -= mu; s2 += y[e] * y[e]; }
        s2 += __shfl_xor(s2, 1); s2 += __shfl_xor(s2, 2); s2 += __shfl_xor(s2, 4);
        const float rstd = rsqrtf(s2 * (1.0f / 64.0f) + 64e-5f);
        float o[8];
#pragma unroll
        for (int e = 0; e < 8; ++e) o[e] = (y[e] * rstd * lw[e] + lb[e] + bo * bfs(v8[e])) * bfs(gg[e]);
        uint4 st; st.x = pk2(o[0], o[1]); st.y = pk2(o[2], o[3]); st.z = pk2(o[4], o[5]); st.w = pk2(o[6], o[7]);
        *(uint4*)rb = st;
    }
}

#define KP (*kargs())
__global__ __launch_bounds__(512) void mega(P pdummy) {
    cg::grid_group grid = cg::this_grid();
    LAS unsigned char* lds = (LAS unsigned char*)smem;
    for (int l = 0; l < 2; ++l) {
        const bool last = l == 1;
        phase_W(KP, l); grid.sync();
        for (int hf = 0; hf < 2; ++hf) {
            { unsigned char* ws = kargs()->ws; phase_norm(KP, l, 0, hf * HROWS, HROWS, (bf16_t*)(ws + OFF_B + B_HH), l == 0, false); } grid.sync();
            {   unsigned char* ws = kargs()->ws;
                Gemm g; g.A = (const bf16_t*)(ws + OFF_B + B_HH); g.Bt = (const bf16_t*)(ws + OFF_WIN1); g.lda = 1024; g.ldb = 1024; g.K = 1024;
                SchedStd S; S.init(68, last ? 15 : 14, 0);
                EpiIn E; E.qkv = (bf16_t*)(ws + OFF_B + B_QKV); E.rw = (bf16_t*)(ws + OFF_B + B_RW); E.sg = (bf16_t*)(ws + OFF_B + B_SG); E.hd = (bf16_t*)(ws + OFF_B + B_HD);
                gemm_phase(lds, g, S, E); }
            grid.sync();
            phase_prep(KP, l, hf); grid.sync();
        }
        {   unsigned char* ws = kargs()->ws;
            Gemm g; g.A = (const bf16_t*)(ws + OFF_AL); g.Bt = (const bf16_t*)(ws + OFF_WGL); g.lda = 256; g.ldb = 256; g.K = 256;
            { SchedStd S; S.init(136, 2, 0); EpiPlain E; E.o = (bf16_t*)(ws + OFF_B + B_G); E.ld = 512; E.act = 0; gemm_phase(lds, g, S, E); }
            g.Bt = (const bf16_t*)(ws + OFF_WGL) + 512 * 256;
            { SchedStd S; S.init(136, 4, 0); EpiAsum E; E.asum = (bf16_t*)(ws + OFF_B + B_ASUM); E.a0 = kargs()->rwkv_a0 + l * 1024; gemm_phase(lds, g, S, E); } }
        grid.sync();
        phase_mix(KP, l); grid.sync();
        phase_post(KP, l); grid.sync();
        for (int hf = 0; hf < 2; ++hf) {
            { unsigned char* ws = kargs()->ws; phase_norm(KP, l, 0, hf * HROWS, HROWS, (bf16_t*)(ws + OFF_B + B_HH), l == 0, last); } grid.sync();
            {   unsigned char* ws = kargs()->ws;
                Gemm g; g.A = (const bf16_t*)(ws + OFF_B + B_HH); g.Bt = (const bf16_t*)(ws + OFF_WGATE); g.lda = 1024; g.ldb = 1024; g.K = 1024;
                SchedStd S; S.init(last ? 64 : 68, 12, 0);
                EpiPlain E; E.o = (bf16_t*)(ws + OFF_B + B_GATE); E.ld = 3072; E.act = 1;
                gemm_phase(lds, g, S, E); }
            grid.sync();
            {   unsigned char* ws = kargs()->ws;
                Gemm g; const bf16_t* big = (const bf16_t*)(ws + OFF_BIG) + (size_t)hf * HROWS * LDB;
                g.A = big;
                g.Bt = (const bf16_t*)(ws + OFF_WO3); g.lda = LDB; g.ldb = 512; g.K = 512;
                SchedMerge S; S.init(last ? 256 : 272);
                EpiMerge E; E.gate = (const bf16_t*)(ws + OFF_B + B_GATE); E.M = (bf16_t*)(ws + OFF_M); E.row0 = hf * HROWS;
                gemm_phase(lds, g, S, E); }
            grid.sync();
        }
        {   CP* kp = kargs(); unsigned char* ws = kp->ws;
            Gemm g; g.A = (const bf16_t*)(ws + OFF_M); g.Bt = (const bf16_t*)(ws + OFF_WOUT); g.lda = 1024; g.ldb = 1024; g.K = 1024;
            SchedStd S; S.init(last ? 128 : 136, 4, last ? 1 : 0);
            EpiRes E; E.gmod = (const float*)(ws + OFF_MOD) + (size_t)l * 9 * 6144 + 2 * 1024; E.xin = kp->x; E.cin = kp->ctx; E.xo = kp->out; E.co = (float*)(ws + OFF_XSC); E.readInput = l == 0;
            gemm_phase(lds, g, S, E); }
        grid.sync();
        { unsigned char* ws = kargs()->ws; phase_norm(KP, l, 1, 0, NROW, (bf16_t*)(ws + OFF_B + B_HH), false, last); } grid.sync();
        {   unsigned char* ws = kargs()->ws;
            Gemm g; g.A = (const bf16_t*)(ws + OFF_B + B_HH); g.Bt = (const bf16_t*)(ws + OFF_W13); g.lda = 1024; g.ldb = 1024; g.K = 1024;
            SchedStd S; S.init(last ? 128 : 136, 22, last ? 1 : 0);
            EpiSwi E; E.U = (bf16_t*)(ws + OFF_U);
            gemm_phase(lds, g, S, E); }
        grid.sync();
        {   CP* kp = kargs(); unsigned char* ws = kp->ws;
            Gemm g; g.A = (const bf16_t*)(ws + OFF_U); g.Bt = (const bf16_t*)(ws + OFF_W2); g.lda = FF; g.ldb = FF; g.K = FF;
            SchedStd S; S.init(last ? 128 : 136, 4, last ? 1 : 0);
            EpiRes E; E.gmod = (const float*)(ws + OFF_MOD) + (size_t)l * 9 * 6144 + 5 * 1024; E.xin = kp->x; E.cin = kp->ctx; E.xo = kp->out; E.co = (float*)(ws + OFF_XSC); E.readInput = 0;
            gemm_phase(lds, g, S, E); }
        grid.sync();
    }
}

extern "C" void kernel_launch(void* const* d_in, const int* in_sizes, int n_in, void* d_out, int out_size, void* d_ws, size_t ws_size, hipStream_t stream) {
    if (n_in < 37 || ws_size < WS_TOTAL) { fprintf(stderr, "kernel_launch: bad inputs (n_in %d, ws %zu < %zu)\n", n_in, ws_size, (size_t)WS_TOTAL); return; }
    P p{};
    const float** pp = (const float**)&p;
    for (int i = 0; i < 37; ++i) pp[i] = (const float*)d_in[i];
    p.out = (float*)d_out; p.ws = (unsigned char*)d_ws;
    static int grid_blocks = 0;
    if (!grid_blocks) {
        int dev = 0, cus = 0, per_cu = 0;
        hipGetDevice(&dev); hipDeviceGetAttribute(&cus, hipDeviceAttributeMultiprocessorCount, dev);
        hipOccupancyMaxActiveBlocksPerMultiprocessor(&per_cu, mega, 512, 0);
        if (per_cu < 1) per_cu = 1;
        grid_blocks = cus;
        if (grid_blocks > 256) grid_blocks = 256;
    }
    void* args[] = {&p};
    hipError_t e = hipLaunchCooperativeKernel((void*)mega, dim3(grid_blocks), dim3(512), args, 0, stream);
    if (e != hipSuccess) fprintf(stderr, "cooperative launch failed: %s (grid %d)\n", hipGetErrorString(e), grid_blocks);
}
```

```cpp
#include <hip/hip_runtime.h>
#include <hip/hip_cooperative_groups.h>
#include <cstdio>
namespace cg = cooperative_groups;

#define LAS __attribute__((address_space(3)))
typedef unsigned short bf16_t;
typedef short bf16x8 __attribute__((ext_vector_type(8)));
typedef short bf16x4 __attribute__((ext_vector_type(4)));
typedef float f32x4 __attribute__((ext_vector_type(4)));
typedef float f32x2 __attribute__((ext_vector_type(2)));
typedef unsigned u32x2 __attribute__((ext_vector_type(2)));

constexpr int NROW = 34816, HROWS = 17408, DM = 1024, LDB = 2688;
constexpr int C_RKV = 640, C_SGU = 2176;
constexpr int FF = 2816;

constexpr size_t OFF_WIN1 = 0, OFF_WGATE = 7864320, OFF_WO3 = 14155776, OFF_WOUT = 17301504, OFF_W13 = 19398656, OFF_W2 = 30932992,
                 OFF_WGL = 36700160, OFF_WWA = 37486592, OFF_WSGU = 37748736, OFF_MOD = 37879808, OFF_ROPE = 38322176, OFF_XSC = 39370752,
                 OFF_V0 = 47759360, OFF_RINV = 83410944, OFF_BIG = 84525056, OFF_AL = 271695872, OFF_VNT = OFF_AL + 17825792,
                 OFF_VT = OFF_VNT + 35651584, OFF_B = 342999040, WS_TOTAL = 504545280;
constexpr size_t OFF_M = OFF_AL, OFF_U = OFF_BIG;
constexpr size_t B_HH = 0, B_QKV = 35651584, B_RW = 62390272, B_SG = 124780544, B_HD = 160432128;
constexpr size_t B_G = 0, B_ASUM = 35651584, B_Y = 71303168;
constexpr size_t B_GATE = 35651584;

struct P {
    const float *x, *c, *ctx, *c_ctx, *w_mod, *b_mod, *norm_mix, *norm_ffn, *w_in, *q_gain, *k_gain, *attn_sink, *rwkv_conv, *rwkv_w0, *rwkv_w_up,
        *rwkv_a0, *rwkv_a_up, *rwkv_k_k, *rwkv_k_a, *rwkv_r_k, *rwkv_g_up, *rwkv_ln_w, *rwkv_ln_b, *vres_down, *vres_up, *vres_b, *sgu_ln_w, *sgu_ln_b,
        *sgu_w, *sgu_b, *w_o_attn, *w_o_rwkv, *w_o_sgu, *w_out, *ffn_w1, *ffn_w3, *ffn_w2;
    float* out;
    unsigned char* ws;
};


typedef const __attribute__((address_space(4))) P CP;
#define PREF CP&
__device__ __forceinline__ int ltid() { int t = threadIdx.x; asm volatile("" : "+v"(t)); return t; }
__device__ __forceinline__ f32x4 zf4() { float z = 0.f; asm volatile("" : "+v"(z)); return (f32x4){z, z, z, z}; }
__device__ __forceinline__ int lbid() { int t = blockIdx.x; asm volatile("" : "+s"(t)); return t; }
__device__ __forceinline__ CP* kargs() { CP* k = (CP*)__builtin_amdgcn_kernarg_segment_ptr(); asm volatile("" : "+s"(k)); return k; }

__shared__ __attribute__((aligned(16))) unsigned char smem[163840];

typedef __bf16 hbf2 __attribute__((ext_vector_type(2)));
__device__ __forceinline__ unsigned cvtpk(float lo, float hi) { const f32x2 v = {lo, hi}; return __builtin_bit_cast(unsigned, __builtin_convertvector(v, hbf2)); }
__device__ __forceinline__ bf16_t f2bf(float f) { return (bf16_t)(cvtpk(f, f) & 0xffffu); }
__device__ __forceinline__ float bf2f(bf16_t b) { return __uint_as_float(((unsigned)b) << 16); }
__device__ __forceinline__ float bfs(short b) { return __uint_as_float(((unsigned)(unsigned short)b) << 16); }
__device__ __forceinline__ unsigned pk2(float lo, float hi) { return cvtpk(lo, hi); }
__device__ __forceinline__ float sigm(float x) { return __builtin_amdgcn_rcpf(1.0f + __expf(-x)); }
__device__ __forceinline__ float gelu_t(float x) { float u = 0.7978845608f * (x + 0.044715f * x * x * x); float t = 1.0f - 2.0f * __builtin_amdgcn_rcpf(1.0f + __expf(2.0f * u)); return 0.5f * x * (1.0f + t); }
__device__ __forceinline__ float wsum(float v) { for (int o = 32; o > 0; o >>= 1) v += __shfl_xor(v, o); return v; }
__device__ __forceinline__ void rowinfo(int r, int& b, int& t, bool& isctx) {
    int hf = r >= HROWS ? 1 : 0, rr = r - hf * HROWS;
    if (rr < 16384) { isctx = false; b = hf * 4 + (rr >> 12); t = rr & 4095; } else { isctx = true; rr -= 16384; b = hf * 4 + (rr >> 8); t = rr & 255; }
}
__device__ __forceinline__ int seg_lat(int b) { return (b >> 2) * HROWS + (b & 3) * 4096; }
__device__ __forceinline__ int seg_ctx(int b) { return (b >> 2) * HROWS + 16384 + (b & 3) * 256; }
__device__ __forceinline__ float dppf(float x, int) = delete;
#define DPP_F(x, ctrl) __int_as_float(__builtin_amdgcn_update_dpp(0, __float_as_int(x), ctrl, 0xF, 0xF, true))
__device__ __forceinline__ float red16(float v) { v += DPP_F(v, 0xB1); v += DPP_F(v, 0x4E); v += DPP_F(v, 0x141); v += DPP_F(v, 0x140); return v; }
__device__ __forceinline__ float red8(float v) { v += DPP_F(v, 0xB1); v += DPP_F(v, 0x4E); v += DPP_F(v, 0x141); return v; }

constexpr int BM = 256, BK = 64, HALF = 128, HTB = HALF * BK * 2, NXCD = 8, WGM = 8;
__device__ __forceinline__ int lds_byte(int r, int c) { const int st = (r >> 4) * 2 + (c >> 5), rr = r & 15, cc = c & 31, ob = rr * 64 + cc * 2; return st * 1024 + (ob ^ (((ob >> 9) & 1) << 5)); }
__device__ __forceinline__ void stage_rc(int b, int& R, int& C) { const int st = b / 1024, sb = b % 1024, swz = sb ^ (((sb >> 9) & 1) << 5); R = (st >> 1) * 16 + swz / 64; C = (st & 1) * 32 + (swz % 64) / 2; }
struct Unit { int pm, pn, w; };
struct UV { const char *cA, *cB; unsigned vA0, vB0; size_t hA, hB; int nt; };
__device__ __forceinline__ int perm32(int rho) { const int n = rho >> 4, i = rho & 15; return 8 * (i >> 2) + 4 * n + (i & 3); }
__device__ __forceinline__ void uv_fill(UV& v, const char* A, int lda, int pm, const char* Bt, int ldb, int pn, int K, int tid, bool perm) {
    int R0, C0; stage_rc(tid * 16, R0, C0); const int Rb = perm ? ((R0 & ~31) + perm32(R0 & 31)) : R0;
    v.vA0 = (unsigned)(R0 * lda + C0) * 2u; v.vB0 = (unsigned)(Rb * ldb + C0) * 2u;
    v.hA = (size_t)HALF * lda * 2; v.hB = (size_t)HALF * ldb * 2; v.cA = A + (size_t)pm * 2 * v.hA; v.cB = Bt + (size_t)pn * 2 * v.hB; v.nt = K / BK;
}
struct Gemm { const bf16_t *A, *Bt; int lda, ldb, K; bool perm;
    __device__ __forceinline__ void view(const Unit& u, int tid, UV& v) const {
        uv_fill(v, (const char*)A + (u.w == 1 ? C_RKV * 2 : (u.w == 2 ? C_SGU * 2 : 0)), lda, u.pm, (const char*)Bt + (size_t)u.w * (1024 * 512 * 2), ldb, u.pn, K, tid, perm); } };
struct GemmGM {
    const bf16_t *H, *Wg, *BIGp, *Wo;
    __device__ __forceinline__ void view(const Unit& u, int tid, UV& v) const {
        const int k = u.w >> 1;
        if (u.w & 1) uv_fill(v, (const char*)BIGp + (k == 1 ? C_RKV * 2 : (k == 2 ? C_SGU * 2 : 0)), LDB, u.pm, (const char*)Wo + (size_t)k * (1024 * 512 * 2), 512, u.pn, 512, tid, true);
        else uv_fill(v, (const char*)H, 1024, u.pm, (const char*)Wg + (size_t)k * (1024 * 1024 * 2), 1024, u.pn, 1024, tid, true); } };
struct SchedStd {
    int nM, nN, nwg, G, c, skip;
    __device__ void init(int nM_, int nN_, int skip_) { nM = nM_; nN = nN_; nwg = nM * nN; G = gridDim.x; c = lbid(); skip = skip_; }
    __device__ void init_sub(int nM_, int nN_, int G_, int c_) { nM = nM_; nN = nN_; nwg = nM * nN; G = G_; c = c_; skip = 0; }
    __device__ bool next(int i, Unit& u) const {
        const long L = (long)i * G + c; if (L >= nwg) return false;
        int wgid = (int)L; { const int q = nwg / NXCD, r = nwg % NXCD, xcd = wgid % NXCD, off = wgid / NXCD; wgid = (xcd < r ? xcd * (q + 1) : r * (q + 1) + (xcd - r) * q) + off; }
        const int nig = WGM * nN, gid = wgid / nig, fm = gid * WGM, gsz = (nM - fm) < WGM ? (nM - fm) : WGM;
        u.pm = fm + ((wgid % nig) % gsz); u.pn = (wgid % nig) / gsz; u.w = 0;
        if (skip && u.pm >= 64) u.pm += 4;
        return true;
    }
};
struct SchedMerge {
    int ntile, G, c;
    __device__ void init(int ntile_) { ntile = ntile_; G = gridDim.x; c = lbid(); }
    __device__ bool next(int i, Unit& u) const { const int ti = (i / 3) * G + c; if (ti >= ntile) return false; u.pm = ti >> 2; u.pn = ti & 3; u.w = i % 3; return true; }
};

struct SchedGM {
    int ntile, G, c, skip;
    __device__ void init(int ntile_, int skip_) { ntile = ntile_; G = gridDim.x; c = lbid(); skip = skip_; }
    __device__ bool next(int i, Unit& u) const { const int ti = (i / 6) * G + c; if (ti >= ntile) return false; u.pm = ti >> 2; u.pn = ti & 3; u.w = i % 6; if (skip && u.pm >= 64) u.pm += 4; return true; }
};
template <class GM, class Epi, class Sched>
__device__ __forceinline__ void gemm_phase(LAS unsigned char* lds, const GM& g, const Sched& S, const Epi& E) {
    const int tid = ltid(), wid = __builtin_amdgcn_readfirstlane(tid >> 6), lane = tid & 63, wr = wid >> 2, wc = wid & 3, fr = lane & 15, fq = lane >> 4;
    const size_t kstep = (size_t)(BK * 2);
    const unsigned ldsw = (unsigned)wid * 1024u;
    const int aoff = lds_byte(wr * 64 + fr, fq * 8), boff = lds_byte(wc * 32 + fr, fq * 8);
#define PG8_SA(b, h) (((b) * 2 + (h)) * HTB)
#define PG8_SB(b, h) ((4 + (b) * 2 + (h)) * HTB)
#define PG8_STAGE(bufoff, gbase, V0, HS) do { \
        __builtin_amdgcn_global_load_lds((const unsigned*)((const char*)(gbase) + (V0)), (LAS unsigned*)(lds + (bufoff) + ldsw), 16, 0, 0); \
        __builtin_amdgcn_global_load_lds((const unsigned*)((const char*)(gbase) + ((HS) >> 1) + (V0)), (LAS unsigned*)(lds + (bufoff) + ldsw + 8192), 16, 0, 0); } while (0)
#define PG8_LDA(dst, b, h) do { _Pragma("unroll") for (int m = 0; m < 4; ++m) _Pragma("unroll") for (int k = 0; k < 2; ++k) dst[m][k] = *(const LAS bf16x8*)(lds + PG8_SA(b, h) + aoff + m * 2048 + k * 1024); } while (0)
#define PG8_LDB(dst, b, h) do { _Pragma("unroll") for (int n = 0; n < 2; ++n) _Pragma("unroll") for (int k = 0; k < 2; ++k) dst[n][k] = *(const LAS bf16x8*)(lds + PG8_SB(b, h) + boff + n * 2048 + k * 1024); } while (0)
#define PG8_MMA(ai, bj, At, Bt) do { __builtin_amdgcn_s_setprio(1); _Pragma("unroll") for (int m = 0; m < 4; ++m) _Pragma("unroll") for (int n = 0; n < 2; ++n) _Pragma("unroll") for (int k = 0; k < 2; ++k) \
        acc[ai][bj][m][n] = __builtin_amdgcn_mfma_f32_16x16x32_bf16(Bt[n][k], At[m][k], acc[ai][bj][m][n], 0, 0, 0); __builtin_amdgcn_s_setprio(0); } while (0)
#define PG8_WAIT_V(n) asm volatile("s_waitcnt vmcnt(" #n ")" ::: "memory")
#define PG8_WAIT_L(n) asm volatile("s_waitcnt lgkmcnt(" #n ")" ::: "memory")
#define PG8_BAR __builtin_amdgcn_s_barrier()
#define PG8_SCHED __builtin_amdgcn_sched_barrier(0)
    Unit cur, nxt; int ui = 0;
    if (!S.next(0, cur)) return;
    f32x4 acc[2][2][4][2]; f32x4 zacc = zf4();
#pragma unroll
    for (int a = 0; a < 2; ++a)
#pragma unroll
        for (int b = 0; b < 2; ++b)
#pragma unroll
            for (int m = 0; m < 4; ++m)
#pragma unroll
                for (int n = 0; n < 2; ++n) acc[a][b][m][n] = zacc;
    bf16x8 At[4][2], B0[2][2], B1[2][2];
    UV C, N; g.view(cur, tid, C);
    PG8_STAGE(PG8_SB(0, 0), C.cB, C.vB0, C.hB); PG8_STAGE(PG8_SA(0, 0), C.cA, C.vA0, C.hA); PG8_STAGE(PG8_SB(0, 1), C.cB + C.hB, C.vB0, C.hB); PG8_STAGE(PG8_SA(0, 1), C.cA + C.hA, C.vA0, C.hA);
    if (wr == 1) PG8_BAR;
    PG8_WAIT_V(4); PG8_BAR;
    PG8_STAGE(PG8_SB(1, 0), C.cB + kstep, C.vB0, C.hB); PG8_STAGE(PG8_SA(1, 0), C.cA + kstep, C.vA0, C.hA); PG8_STAGE(PG8_SB(1, 1), C.cB + C.hB + kstep, C.vB0, C.hB);
    PG8_WAIT_V(6); PG8_BAR;
    for (;;) {
        const bool has_next = S.next(ui + 1, nxt);
        if (has_next) g.view(nxt, tid, N); else N = C;
        const int nt = C.nt;
        for (int t = 0; t < nt; t += 2) {
            const bool last = (t == nt - 2);
            const char* a1 = C.cA + (size_t)(t + 1) * kstep;
            const char* a2 = last ? N.cA : C.cA + (size_t)(t + 2) * kstep; const char* b2 = last ? N.cB : C.cB + (size_t)(t + 2) * kstep;
            const char* a3 = a2 + kstep; const char* b3 = b2 + kstep;
            const unsigned xa0 = last ? N.vA0 : C.vA0, xb0 = last ? N.vB0 : C.vB0;
            const size_t xhA = last ? N.hA : C.hA, xhB = last ? N.hB : C.hB;
            PG8_LDB(B0, 0, 0); PG8_SCHED; PG8_LDA(At, 0, 0); PG8_STAGE(PG8_SA(1, 1), a1 + C.hA, C.vA0, C.hA);
            PG8_WAIT_L(8); PG8_BAR; PG8_WAIT_L(0); PG8_MMA(0, 0, At, B0); PG8_BAR; PG8_SCHED;
            PG8_LDB(B1, 0, 1); PG8_STAGE(PG8_SB(0, 0), b2, xb0, xhB);
            PG8_BAR; PG8_WAIT_L(0); PG8_MMA(0, 1, At, B1); PG8_BAR;
            PG8_LDA(At, 0, 1); PG8_STAGE(PG8_SA(0, 0), a2, xa0, xhA);
            PG8_BAR; PG8_WAIT_L(0); PG8_MMA(1, 0, At, B0); PG8_BAR; PG8_SCHED;
            PG8_STAGE(PG8_SB(0, 1), b2 + xhB, xb0, xhB);
            PG8_WAIT_V(6); PG8_BAR; PG8_MMA(1, 1, At, B1); PG8_BAR;
            PG8_LDB(B0, 1, 0); PG8_SCHED; PG8_LDA(At, 1, 0); PG8_STAGE(PG8_SA(0, 1), a2 + xhA, xa0, xhA);
            PG8_WAIT_L(8); PG8_BAR; PG8_WAIT_L(0); PG8_MMA(0, 0, At, B0); PG8_BAR; PG8_SCHED;
            PG8_LDB(B1, 1, 1); PG8_STAGE(PG8_SB(1, 0), b3, xb0, xhB);
            PG8_BAR; PG8_WAIT_L(0); PG8_MMA(0, 1, At, B1); PG8_BAR;
            PG8_LDA(At, 1, 1); PG8_STAGE(PG8_SA(1, 0), a3, xa0, xhA);
            PG8_BAR; PG8_WAIT_L(0); PG8_MMA(1, 0, At, B0); PG8_BAR; PG8_SCHED;
            PG8_STAGE(PG8_SB(1, 1), b3 + xhB, xb0, xhB);
            PG8_WAIT_V(6); PG8_BAR; PG8_MMA(1, 1, At, B1); PG8_BAR;
        }
        E(acc, cur, wr, wc, fr, fq);
        if (!has_next) break;
        zacc = zf4();
#pragma unroll
        for (int a = 0; a < 2; ++a)
#pragma unroll
            for (int b = 0; b < 2; ++b)
#pragma unroll
                for (int m = 0; m < 4; ++m)
#pragma unroll
                    for (int n = 0; n < 2; ++n) acc[a][b][m][n] = zacc;
        cur = nxt; C = N; ++ui;
    }
    PG8_WAIT_V(0);
    if (wr == 0) PG8_BAR;
    PG8_BAR;
}

#define EPI_LOOP_ROWS for (int ai = 0; ai < 2; ++ai) for (int m = 0; m < 4; ++m, __builtin_amdgcn_sched_barrier(0))
#define EPI_LOOP_COLS for (int bj = 0; bj < 2; ++bj) for (int n = 0; n < 2; ++n)
#define EPI_LOOP_COLS_SB for (int bj = 0; bj < 2; ++bj) for (int n = 0; n < 2; ++n, __builtin_amdgcn_sched_barrier(0))
__device__ __forceinline__ void st_bf4(bf16_t* p, f32x4 v) { uint2 o; o.x = pk2(v[0], v[1]); o.y = pk2(v[2], v[3]); *(uint2*)p = o; }

__device__ __forceinline__ void st_bf8(bf16_t* p, f32x4 a, f32x4 b) { uint4 o; o.x = pk2(a[0], a[1]); o.y = pk2(a[2], a[3]); o.z = pk2(b[0], b[1]); o.w = pk2(b[2], b[3]); *(uint4*)p = o; }
struct EpiIn {
    bf16_t *qkv, *rw, *sg, *hd;
    __device__ __forceinline__ void operator()(const f32x4 (&acc)[2][2][4][2], const Unit& u, int wr, int wc, int fr, int fq) const {
        asm volatile("" : "+v"(fr), "+v"(fq));
        bf16_t* base; int ld, c0;
        if (u.pn < 3) { base = qkv; ld = 768; c0 = u.pn * 256; } else if (u.pn < 10) { base = rw; ld = 1792; c0 = (u.pn - 3) * 256; }
        else if (u.pn < 14) { base = sg; ld = 1024; c0 = (u.pn - 10) * 256; } else { base = hd; ld = 32; c0 = 0; }
        const bool hdt = u.pn >= 14;
#pragma unroll
        EPI_LOOP_ROWS { const int row = u.pm * 256 + ai * 128 + wr * 64 + m * 16 + fr;
#pragma unroll
            for (int bj = 0; bj < 2; ++bj) { const int col = bj * 128 + wc * 32 + fq * 8; if (hdt && (bj != 0 || wc != 0)) continue; st_bf8(base + (size_t)row * ld + c0 + col, acc[ai][bj][m][0], acc[ai][bj][m][1]); } }
    }
};
struct EpiPlain {
    bf16_t* o; int ld; int act;
    __device__ __forceinline__ void operator()(const f32x4 (&acc)[2][2][4][2], const Unit& u, int wr, int wc, int fr, int fq) const {
        asm volatile("" : "+v"(fr), "+v"(fq));
#pragma unroll
        EPI_LOOP_ROWS { const int row = u.pm * 256 + ai * 128 + wr * 64 + m * 16 + fr;
#pragma unroll
            for (int bj = 0; bj < 2; ++bj) { const int col = u.pn * 256 + bj * 128 + wc * 32 + fq * 8; f32x4 v = acc[ai][bj][m][0], w = acc[ai][bj][m][1];
                if (act) { v[0] = sigm(v[0]); v[1] = sigm(v[1]); v[2] = sigm(v[2]); v[3] = sigm(v[3]); w[0] = sigm(w[0]); w[1] = sigm(w[1]); w[2] = sigm(w[2]); w[3] = sigm(w[3]); }
                st_bf8(o + (size_t)row * ld + col, v, w); } }
    }
};
struct EpiAsum {
    bf16_t* asum; const float* a0;
    __device__ __forceinline__ void operator()(const f32x4 (&acc)[2][2][4][2], const Unit& u, int wr, int wc, int fr, int fq) const {
        asm volatile("" : "+v"(fr), "+v"(fq));
        const int col0 = u.pn * 128 + wc * 32 + fq * 8;
        f32x4 b0[2], b1[2];
#pragma unroll
        for (int n = 0; n < 2; ++n) { b0[n] = *(const f32x4*)(a0 + col0 + n * 4); b1[n] = *(const f32x4*)(a0 + 512 + col0 + n * 4); }
#pragma unroll
        EPI_LOOP_ROWS { const int row = u.pm * 256 + ai * 128 + wr * 64 + m * 16 + fr; f32x4 v[2];
#pragma unroll
            for (int n = 0; n < 2; ++n)
#pragma unroll
                for (int e = 0; e < 4; ++e) v[n][e] = sigm(b0[n][e] + acc[ai][0][m][n][e]) + sigm(b1[n][e] + acc[ai][1][m][n][e]);
            st_bf8(asum + (size_t)row * 512 + col0, v[0], v[1]); }
    }
};
struct EpiMerge {
    const bf16_t* gate; bf16_t* M; int row0;
    __device__ __forceinline__ void operator()(const f32x4 (&acc)[2][2][4][2], const Unit& u, int wr, int wc, int fr, int fq) const {
        asm volatile("" : "+v"(fr), "+v"(fq));
#pragma unroll
        EPI_LOOP_ROWS { const int row = u.pm * 256 + ai * 128 + wr * 64 + m * 16 + fr;
#pragma unroll
            EPI_LOOP_COLS { const int col = u.pn * 256 + bj * 128 + wc * 32 + n * 16 + fq * 4;
                const bf16x4 gt = *(const bf16x4*)(gate + (size_t)row * 3072 + u.w * 1024 + col);
                bf16_t* mp = M + (size_t)(row0 + row) * 1024 + col; f32x4 v;
#pragma unroll
                for (int e = 0; e < 4; ++e) v[e] = bfs(gt[e]) * acc[ai][bj][m][n][e];
                if (u.w != 0) { const bf16x4 old = *(const bf16x4*)mp;
#pragma unroll
                    for (int e = 0; e < 4; ++e) v[e] += bfs(old[e]); }
                st_bf4(mp, v); } }
    }
};
struct EpiGM {
    bf16_t* scr; bf16_t* M;
    __device__ __forceinline__ void operator()(const f32x4 (&acc)[2][2][4][2], const Unit& u, int wr, int wc, int fr, int fq) const {
        asm volatile("" : "+v"(fr), "+v"(fq));
        bf16_t* scr = this->scr; asm volatile("" : "+s"(scr));
        if (!(u.w & 1)) {
#pragma unroll
            EPI_LOOP_ROWS { const int rl = ai * 128 + wr * 64 + m * 16 + fr;
#pragma unroll
                EPI_LOOP_COLS_SB { const int cl = bj * 128 + wc * 32 + fq * 8 + n * 4; f32x4 v = acc[ai][bj][m][n];
                    v[0] = sigm(v[0]); v[1] = sigm(v[1]); v[2] = sigm(v[2]); v[3] = sigm(v[3]); u32x2 o2; o2[0] = pk2(v[0], v[1]); o2[1] = pk2(v[2], v[3]); *(__attribute__((address_space(1))) u32x2*)(scr + rl * 256 + cl) = o2; } }
        } else {
#pragma unroll
            for (int ai = 0; ai < 2; ++ai) {
                u32x2 gr[4][2][2]; bf16x4 od[4][2][2];
#pragma unroll
                for (int m = 0; m < 4; ++m) { const int rl = ai * 128 + wr * 64 + m * 16 + fr, row = u.pm * 256 + rl;
#pragma unroll
                    for (int bj = 0; bj < 2; ++bj)
#pragma unroll
                        for (int n = 0; n < 2; ++n) { const int cl = bj * 128 + wc * 32 + fq * 8 + n * 4, col = u.pn * 256 + cl;
                            { const unsigned long long gq = __hip_atomic_load((const __attribute__((address_space(1))) unsigned long long*)(scr + rl * 256 + cl), __ATOMIC_RELAXED, __HIP_MEMORY_SCOPE_AGENT);
                              gr[m][bj][n] = __builtin_bit_cast(u32x2, gq); }
                            od[m][bj][n] = (u.w != 1) ? *(const bf16x4*)(M + (size_t)row * 1024 + col) : (bf16x4){0, 0, 0, 0}; } }
#pragma unroll
                for (int m = 0; m < 4; ++m) { const int rl = ai * 128 + wr * 64 + m * 16 + fr, row = u.pm * 256 + rl;
#pragma unroll
                    for (int bj = 0; bj < 2; ++bj)
#pragma unroll
                        for (int n = 0; n < 2; ++n) { const int cl = bj * 128 + wc * 32 + fq * 8 + n * 4, col = u.pn * 256 + cl; const u32x2 graw = gr[m][bj][n]; f32x4 v;
                            v[0] = __uint_as_float(graw.x << 16) * acc[ai][bj][m][n][0] + bfs(od[m][bj][n][0]); v[1] = __uint_as_float(graw.x & 0xffff0000u) * acc[ai][bj][m][n][1] + bfs(od[m][bj][n][1]);
                            v[2] = __uint_as_float(graw.y << 16) * acc[ai][bj][m][n][2] + bfs(od[m][bj][n][2]); v[3] = __uint_as_float(graw.y & 0xffff0000u) * acc[ai][bj][m][n][3] + bfs(od[m][bj][n][3]);
                            st_bf4(M + (size_t)row * 1024 + col, v); } }
                __builtin_amdgcn_sched_barrier(0);
            }
        }
    }
};
struct EpiRes {
    const float* gmod;
    const float *xin, *cin; float *xo, *co; int readInput;
    __device__ __forceinline__ void operator()(const f32x4 (&acc)[2][2][4][2], const Unit& u, int wr, int wc, int fr, int fq) const {
        asm volatile("" : "+v"(fr), "+v"(fq));
        int b0, t0; bool ic0; rowinfo(u.pm * 256, b0, t0, ic0); const bool ic = __builtin_amdgcn_readfirstlane((int)ic0) != 0;
        const float* sx = xin; const float* sc_ = cin; asm volatile("" : "+s"(sx), "+s"(sc_));
        const float* srcb = (ic ? sc_ : sx) + (ic ? ((size_t)(b0 * 256 + t0) * 1024) : ((size_t)(b0 * 4096 + t0) * 1024));
        float* dstb = (ic ? co : xo) + (ic ? ((size_t)(b0 * 256 + t0) * 1024) : ((size_t)(b0 * 4096 + t0) * 1024));
        const float* gm = gmod + (ic ? 8 : b0) * 6144 + u.pn * 256 + wc * 32 + fq * 4;
        f32x4 gg[2][2];
#pragma unroll
        for (int bj = 0; bj < 2; ++bj)
#pragma unroll
            for (int n = 0; n < 2; ++n) gg[bj][n] = *(const f32x4*)(gm + bj * 128 + n * 16);
#pragma unroll
        for (int ai = 0; ai < 2; ++ai) {
            f32x4 r[4][2][2];
#pragma unroll
            for (int m = 0; m < 4; ++m) { const size_t ro = (size_t)(ai * 128 + wr * 64 + m * 16 + fr) * 1024 + u.pn * 256 + wc * 32 + fq * 4;
#pragma unroll
                for (int bj = 0; bj < 2; ++bj)
#pragma unroll
                    for (int n = 0; n < 2; ++n) r[m][bj][n] = *(const __attribute__((address_space(1))) f32x4*)(srcb + ro + bj * 128 + n * 16); }
#pragma unroll
            for (int m = 0; m < 4; ++m) { const size_t ro = (size_t)(ai * 128 + wr * 64 + m * 16 + fr) * 1024 + u.pn * 256 + wc * 32 + fq * 4;
#pragma unroll
                for (int bj = 0; bj < 2; ++bj)
#pragma unroll
                    for (int n = 0; n < 2; ++n) *(f32x4*)(dstb + ro + bj * 128 + n * 16) = r[m][bj][n] + gg[bj][n] * acc[ai][bj][m][n]; }
            __builtin_amdgcn_sched_barrier(0);
        }
    }
};
struct EpiSwi {
    bf16_t* U;
    __device__ __forceinline__ void operator()(const f32x4 (&acc)[2][2][4][2], const Unit& u, int wr, int wc, int fr, int fq) const {
        asm volatile("" : "+v"(fr), "+v"(fq));
#pragma unroll
        EPI_LOOP_ROWS { const int row = u.pm * 256 + ai * 128 + wr * 64 + m * 16 + fr;
#pragma unroll
            for (int once = 0; once < 1; ++once) { const int col = u.pn * 128 + wc * 32 + fq * 8; f32x4 v[2];
#pragma unroll
              for (int n = 0; n < 2; ++n)
#pragma unroll
                for (int e = 0; e < 4; ++e) { const float a = acc[ai][0][m][n][e]; v[n][e] = a * sigm(a) * acc[ai][1][m][n][e]; }
              st_bf8(U + (size_t)row * FF + col, v[0], v[1]); } }
    }
};

__device__ __forceinline__ void tconv(const float* src, int lds_, int K, int N, bf16_t* dst, int ldd, int mode, int& jobbase) {
    float* tile = (float*)smem;
    const int nkt = K >> 6, nnt = (N + 63) >> 6, njobs = nkt * nnt, G = gridDim.x;
    const int first = (((int)lbid() - jobbase % G) + G) % G;
    const int tid = ltid();
    for (int j0 = first; j0 < njobs; j0 += 2 * G) {
        float v[2][8]; int k0s[2], n0s[2]; bool ok[2];
#pragma unroll
        for (int u = 0; u < 2; ++u) { const int j = j0 + u * G; ok[u] = j < njobs; const int jj = ok[u] ? j : j0; const int kt = jj % nkt, ntile = jj / nkt; k0s[u] = kt << 6; n0s[u] = ntile << 6;
#pragma unroll
            for (int e = 0; e < 8; ++e) { const int k = e * 8 + (tid >> 6), n = tid & 63; v[u][e] = (ok[u] && n0s[u] + n < N) ? src[(size_t)(k0s[u] + k) * lds_ + n0s[u] + n] : 0.f; } }
        __syncthreads();
#pragma unroll
        for (int u = 0; u < 2; ++u)
#pragma unroll
            for (int e = 0; e < 8; ++e) tile[u * 4160 + (e * 8 + (tid >> 6)) * 65 + (tid & 63)] = v[u][e];
        __syncthreads();
#pragma unroll
        for (int u = 0; u < 2; ++u) { const int n = tid >> 3, kq = tid & 7, ng = n0s[u] + n; const float* tl = tile + u * 4160;
            if (ok[u] && ng < N) { const int row = mode == 0 ? ng : ((ng >> 7) * 256 + (ng & 127) + (mode == 2 ? 128 : 0)); uint4 st;
                st.x = pk2(tl[(kq * 8 + 0) * 65 + n], tl[(kq * 8 + 1) * 65 + n]); st.y = pk2(tl[(kq * 8 + 2) * 65 + n], tl[(kq * 8 + 3) * 65 + n]);
                st.z = pk2(tl[(kq * 8 + 4) * 65 + n], tl[(kq * 8 + 5) * 65 + n]); st.w = pk2(tl[(kq * 8 + 6) * 65 + n], tl[(kq * 8 + 7) * 65 + n]);
                *(uint4*)(dst + (size_t)row * ldd + k0s[u] + kq * 8) = st; } }
    }
    jobbase += njobs;
    __syncthreads();
}
__device__ __forceinline__ void zfill(void* ptr, size_t bytes) {
    uint4* q = (uint4*)ptr; const size_t n = bytes >> 4; unsigned z0 = 0; asm volatile("" : "+v"(z0)); const uint4 z = {z0, z0, z0, z0};
    for (size_t i = (size_t)lbid() * 512 + ltid(); i < n; i += (size_t)gridDim.x * 512) q[i] = z;
}
__device__ __forceinline__ void phase_W(PREF p, int l) {
    unsigned char* ws = p.ws; int jb = 0;
    bf16_t* win1 = (bf16_t*)(ws + OFF_WIN1);
    if (l == 1) zfill(win1 + (size_t)(3584 + 32) * 1024, (size_t)224 * 1024 * 2);
    {
        bf16_t* wgl = (bf16_t*)(ws + OFF_WGL);
        for (int i = lbid() * 512 + ltid(); i < 1536 * 256; i += gridDim.x * 512) { const int r = i >> 8, k = i & 255; const bool wr_ = r < 512 ? (k >= 128) : (k >= 64 && k < 128); if (!wr_) wgl[i] = 0; }
    }
    tconv(p.w_in + (size_t)l * 1024 * 6656, 6656, 1024, 3584, win1, 1024, 0, jb);
    if (l == 1) tconv(p.vres_down, 32, 1024, 32, win1 + (size_t)3584 * 1024, 1024, 0, jb);
    tconv(p.w_in + (size_t)l * 1024 * 6656 + 3584, 6656, 1024, 3072, (bf16_t*)(ws + OFF_WGATE), 1024, 0, jb);
    tconv(p.w_o_attn + (size_t)l * 512 * 1024, 1024, 512, 1024, (bf16_t*)(ws + OFF_WO3), 512, 0, jb);
    tconv(p.w_o_rwkv + (size_t)l * 512 * 1024, 1024, 512, 1024, (bf16_t*)(ws + OFF_WO3) + 1024 * 512, 512, 0, jb);
    tconv(p.w_o_sgu + (size_t)l * 512 * 1024, 1024, 512, 1024, (bf16_t*)(ws + OFF_WO3) + 2 * 1024 * 512, 512, 0, jb);
    tconv(p.w_out + (size_t)l * 1024 * 1024, 1024, 1024, 1024, (bf16_t*)(ws + OFF_WOUT), 1024, 0, jb);
    tconv(p.ffn_w1 + (size_t)l * 1024 * FF, FF, 1024, FF, (bf16_t*)(ws + OFF_W13), 1024, 1, jb);
    tconv(p.ffn_w3 + (size_t)l * 1024 * FF, FF, 1024, FF, (bf16_t*)(ws + OFF_W13), 1024, 2, jb);
    tconv(p.ffn_w2 + (size_t)l * FF * 1024, 1024, FF, 1024, (bf16_t*)(ws + OFF_W2), FF, 0, jb);
    tconv(p.rwkv_g_up + (size_t)l * 128 * 512, 512, 128, 512, (bf16_t*)(ws + OFF_WGL) + 128, 256, 0, jb);
    tconv(p.rwkv_a_up + (size_t)(l * 2 + 0) * 64 * 512, 512, 64, 512, (bf16_t*)(ws + OFF_WGL) + 512 * 256 + 64, 256, 1, jb);
    tconv(p.rwkv_a_up + (size_t)(l * 2 + 1) * 64 * 512, 512, 64, 512, (bf16_t*)(ws + OFF_WGL) + 512 * 256 + 64, 256, 2, jb);
    for (int d = 0; d < 2; ++d) {
        tconv(p.rwkv_w_up + (size_t)(l * 2 + d) * 64 * 512, 512, 64, 512, (bf16_t*)(ws + OFF_WWA) + (size_t)(d * 2 + 0) * 512 * 64, 64, 0, jb);
        tconv(p.rwkv_a_up + (size_t)(l * 2 + d) * 64 * 512, 512, 64, 512, (bf16_t*)(ws + OFF_WWA) + (size_t)(d * 2 + 1) * 512 * 64, 64, 0, jb);
    }
    {   bf16_t* wsg = (bf16_t*)(ws + OFF_WSGU); const float* s = p.sgu_w + (size_t)l * 65536;
        for (int i = lbid() * 512 + ltid(); i < 65536; i += gridDim.x * 512) wsg[i] = f2bf(s[i]); }
    if (l == 0) {
        float* cs = (float*)(ws + OFF_ROPE);
        for (int i = lbid() * 512 + ltid(); i < 4096 * 32; i += gridDim.x * 512) { const int t = i >> 5, f = i & 31; const float pos = (float)(f < 16 ? (t >> 6) : (t & 63));
            const float inv = exp2f(-(float)(f & 15) * (13.287712379549449f / 16.0f)); const float ang = pos * inv; cs[2 * i] = __cosf(ang); cs[2 * i + 1] = __sinf(ang); }
        float* sc = (float*)smem; float* red = sc + 9 * 1024; float* mod = (float*)(ws + OFF_MOD);
        __syncthreads();
        for (int i = ltid(); i < 9 * 1024; i += 512) { const float v = i < 8192 ? p.c[i] : p.c_ctx[i - 8192]; sc[i] = v * sigm(v); }
        __syncthreads();
        for (int it = lbid(); it < 192; it += gridDim.x) {
            const int ll = it / 96, j0 = (it % 96) * 64, kg = ltid() >> 6, jj = ltid() & 63;
            float a[9];
#pragma unroll
            for (int r = 0; r < 9; ++r) a[r] = 0.f;
            const float* wp = p.w_mod + (size_t)ll * 1024 * 6144 + j0 + jj;
            for (int i0 = kg * 128; i0 < kg * 128 + 128; i0 += 16) { float wv[16];
#pragma unroll
                for (int u = 0; u < 16; ++u) wv[u] = wp[(size_t)(i0 + u) * 6144];
#pragma unroll
                for (int u = 0; u < 16; ++u)
#pragma unroll
                    for (int r = 0; r < 9; ++r) a[r] += sc[r * 1024 + i0 + u] * wv[u]; }
            __syncthreads();
#pragma unroll
            for (int r = 0; r < 9; ++r) red[(kg * 9 + r) * 64 + jj] = a[r];
            __syncthreads();
            for (int idx = ltid(); idx < 576; idx += 512) { const int r = idx >> 6, j2 = idx & 63; float s = 0.f; for (int k2 = 0; k2 < 8; ++k2) s += red[(k2 * 9 + r) * 64 + j2];
                mod[(size_t)(ll * 9 + r) * 6144 + j0 + j2] = s + p.b_mod[(size_t)ll * 6144 + j0 + j2]; }
        }
        __syncthreads();
    }
}

__device__ __forceinline__ void phase_norm(PREF p, int l, int which, int r0, int nrows, bf16_t* dst, bool readInput, bool skipctx) {
    const int lane = ltid() & 63, gw = lbid() * 8 + (ltid() >> 6), nw = gridDim.x * 8;
    const float* mod = (const float*)(p.ws + OFF_MOD) + (size_t)l * 9 * 6144; const float* xsc = (const float*)(p.ws + OFF_XSC);
    const float* gain = (which ? p.norm_ffn : p.norm_mix) + l * 1024;
    f32x4 gn[4];
#pragma unroll
    for (int e = 0; e < 4; ++e) gn[e] = *(const f32x4*)(gain + e * 256 + lane * 4);
    for (int ri0 = gw; ri0 < nrows; ri0 += 4 * nw) {
        f32x4 v[4][4]; const float* mr[4]; bool act[4];
#pragma unroll
        for (int k = 0; k < 4; ++k) {
            const int ri = ri0 + k * nw; act[k] = ri < nrows; const int r = r0 + (act[k] ? ri : ri0); int b, t; bool ic; rowinfo(r, b, t, ic);
            if (skipctx && ic) act[k] = false;
            const float* src = ic ? ((readInput ? p.ctx : xsc) + (size_t)(b * 256 + t) * 1024) : ((readInput ? p.x : p.out) + (size_t)(b * 4096 + t) * 1024);
            mr[k] = mod + (ic ? 8 : b) * 6144 + (which ? 3 : 0) * 1024;
#pragma unroll
            for (int e = 0; e < 4; ++e) v[k][e] = *(const f32x4*)(src + e * 256 + lane * 4);
        }
#pragma unroll
        for (int k = 0; k < 4; ++k) {
            float ss = 0.f;
#pragma unroll
            for (int e = 0; e < 4; ++e) ss += v[k][e][0] * v[k][e][0] + v[k][e][1] * v[k][e][1] + v[k][e][2] * v[k][e][2] + v[k][e][3] * v[k][e][3];
            ss = wsum(ss); const float rstd = rsqrtf(ss * (1.0f / 1024.0f) + 1e-6f);
            if (act[k]) {
                const int ri = ri0 + k * nw;
#pragma unroll
                for (int e = 0; e < 4; ++e) { const int c = e * 256 + lane * 4; const f32x4 sh = *(const f32x4*)(mr[k] + c), sc = *(const f32x4*)(mr[k] + 1024 + c);
                    f32x4 h = v[k][e] * rstd * gn[e] * (sc + 1.0f) + sh; st_bf4(dst + (size_t)ri * 1024 + c, h); }
            }
        }
    }
}

__device__ __forceinline__ void phase_prep(PREF p, int l, int hf) {
    unsigned char* ws = p.ws; const int tid = ltid(), lane = tid & 63, wave = tid >> 6;
    const bf16_t* QKVh = (const bf16_t*)(ws + OFF_B + B_QKV); const bf16_t* RWh = (const bf16_t*)(ws + OFF_B + B_RW);
    const bf16_t* SGh = (const bf16_t*)(ws + OFF_B + B_SG); const bf16_t* HDh = (const bf16_t*)(ws + OFF_B + B_HD);
    bf16_t* BIG = (bf16_t*)(ws + OFF_BIG); bf16_t* AL = (bf16_t*)(ws + OFF_AL); bf16_t* vnT = (bf16_t*)(ws + OFF_VNT);
    bf16_t* vTl = (bf16_t*)(ws + OFF_VT); bf16_t* vTc = vTl + (size_t)8 * 128 * 4096; bf16_t* V0 = (bf16_t*)(ws + OFF_V0); float* RINV = (float*)(ws + OFF_RINV);
    const float* cs = (const float*)(ws + OFF_ROPE);
    bf16_t* lt = (bf16_t*)smem;
    const int ch = tid * 4; float cw[3][4] = {{0}}, kkw[4] = {0, 0, 0, 0}, vb[4] = {0, 0, 0, 0};
    if (tid < 448) { for (int i = 0; i < 3; ++i) for (int e = 0; e < 4; ++e) cw[i][e] = p.rwkv_conv[(size_t)(l * 3 + i) * 1792 + ch + e]; }
    if (tid >= 128 && tid < 256) for (int e = 0; e < 4; ++e) kkw[e] = p.rwkv_k_k[l * 512 + ch - 512 + e];
    const bool isv = tid >= 256 && tid < 384;
    float* upl = (float*)(smem + 49152);
    if (l == 1) { for (int i = tid; i < 32 * 512; i += 512) upl[i] = p.vres_up[i]; if (isv) for (int e = 0; e < 4; ++e) vb[e] = p.vres_b[ch - 1024 + e]; }
    __syncthreads();
    for (int strip = lbid(); strip < HROWS / 16; strip += gridDim.x) {
        const int rr0 = strip * 16, r0 = hf * HROWS + rr0; int b, t0; bool ic; rowinfo(r0, b, t0, ic);
        const int T = ic ? 256 : 4096;
        {
            const int g = lane & 7;
            bf16x8 raws[2][2]; f32x4 csv[2][4];
#pragma unroll
            for (int i = 0; i < 2; ++i) {
                const int rr = rr0 + wave * 2 + i, t = t0 + wave * 2 + i;
                raws[i][0] = *(const bf16x8*)(QKVh + (size_t)rr * 768 + (lane >> 3) * 64 + g * 8);
                raws[i][1] = *(const bf16x8*)(QKVh + (size_t)rr * 768 + 512 + ((lane >> 3) & 1) * 64 + g * 8);
                const float* cp = cs + (size_t)((ic ? 0 : t) * 32 + (g & 3) * 8) * 2;
#pragma unroll
                for (int q4 = 0; q4 < 4; ++q4) csv[i][q4] = *(const f32x4*)(cp + q4 * 4);
            }
#pragma unroll
            for (int i = 0; i < 2; ++i) {
                const int rr = rr0 + wave * 2 + i, r = hf * HROWS + rr;
#pragma unroll
                for (int pass = 0; pass < 2; ++pass) {
                    const int hh = pass == 0 ? (lane >> 3) : ((lane >> 3) & 1);
                    const int scol = pass == 0 ? hh * 64 + g * 8 : 512 + hh * 64 + g * 8;
                    const bf16x8 raw = raws[i][pass];
                    const float* gn = (pass == 0 ? p.q_gain : p.k_gain) + l * 64 + g * 8;
                    float x[8], ss = 0.f;
#pragma unroll
                    for (int e = 0; e < 8; ++e) { x[e] = bfs(raw[e]); ss += x[e] * x[e]; }
                    ss += __shfl_xor(ss, 1); ss += __shfl_xor(ss, 2); ss += __shfl_xor(ss, 4);
                    const float rstd = rsqrtf(ss * (1.0f / 64.0f) + 1e-6f);
#pragma unroll
                    for (int e = 0; e < 8; ++e) x[e] = x[e] * rstd * gn[e];
                    float y[8];
#pragma unroll
                    for (int e = 0; e < 8; ++e) { const float o = __shfl_xor(x[e], 4);
                        if (ic) y[e] = x[e];
                        else { const float co = csv[i][e >> 1][(e & 1) * 2], si = csv[i][e >> 1][(e & 1) * 2 + 1];
                            y[e] = (g < 4) ? (x[e] * co - o * si) : (o * si + x[e] * co); } }
                    const float scl = pass == 0 ? 0.125f : 1.0f;
                    uint4 st; st.x = pk2(y[0] * scl, y[1] * scl); st.y = pk2(y[2] * scl, y[3] * scl); st.z = pk2(y[4] * scl, y[5] * scl); st.w = pk2(y[6] * scl, y[7] * scl);
                    if (pass == 0 || lane < 16) *(uint4*)(BIG + (size_t)r * LDB + scol) = st;
                }
            }
        }
        __syncthreads();
        if (tid < 256) { const int row = tid >> 4, cq = tid & 15; *(uint4*)(lt + row * 136 + cq * 8) = *(const uint4*)(QKVh + (size_t)(rr0 + row) * 768 + 640 + cq * 8); }
        __syncthreads();
        if (tid < 256) { const int c = tid >> 1, tq = tid & 1; bf16_t tmp[8];
#pragma unroll
            for (int e = 0; e < 8; ++e) tmp[e] = lt[(tq * 8 + e) * 136 + c];
            uint4 st; st.x = tmp[0] | ((unsigned)tmp[1] << 16); st.y = tmp[2] | ((unsigned)tmp[3] << 16); st.z = tmp[4] | ((unsigned)tmp[5] << 16); st.w = tmp[6] | ((unsigned)tmp[7] << 16);
            const int kvh_ = c >> 6, d_ = c & 63, kb_ = t0 >> 6, tt_ = (t0 & 63) + tq * 8;
            bf16_t* dstp = ic ? (vTc + ((size_t)((b * 2 + kvh_) * 4 + kb_) * 64 + d_) * 64 + tt_) : (vTl + ((size_t)((b * 2 + kvh_) * 64 + kb_) * 64 + d_) * 64 + tt_);
            *(uint4*)dstp = st; }
        __syncthreads();
        bf16x8 urs[2], vrs[2];
#pragma unroll
        for (int i = 0; i < 2; ++i) { const int rr = rr0 + wave * 2 + i; urs[i] = *(const bf16x8*)(SGh + (size_t)rr * 1024 + lane * 8); vrs[i] = *(const bf16x8*)(SGh + (size_t)rr * 1024 + 512 + lane * 8); }
#pragma unroll
        for (int i = 0; i < 2; ++i) {
            const int rl = wave * 2 + i, rr = rr0 + rl, r = hf * HROWS + rr;
            const bf16x8 ur = urs[i], vr = vrs[i];
            float u[8], v[8], s1 = 0.f;
#pragma unroll
            for (int e = 0; e < 8; ++e) { u[e] = gelu_t(bfs(ur[e])); v[e] = gelu_t(bfs(vr[e])); s1 += v[e]; }
            uint4 st; st.x = pk2(u[0], u[1]); st.y = pk2(u[2], u[3]); st.z = pk2(u[4], u[5]); st.w = pk2(u[6], u[7]);
            *(uint4*)(BIG + (size_t)r * LDB + C_SGU + lane * 8) = st;
            const float mu = wsum(s1) * (1.0f / 512.0f); float s2 = 0.f;
#pragma unroll
            for (int e = 0; e < 8; ++e) { v[e] -= mu; s2 += v[e] * v[e]; }
            const float rstd = rsqrtf(wsum(s2) * (1.0f / 512.0f) + 1e-6f);
            const float* lw = p.sgu_ln_w + l * 512 + lane * 8; const float* lb = p.sgu_ln_b + l * 512 + lane * 8;
#pragma unroll
            for (int e = 0; e < 8; ++e) lt[rl * 520 + lane * 8 + e] = f2bf(v[e] * rstd * lw[e] + lb[e]);
        }
        __syncthreads();
        { const int c = tid;
#pragma unroll
            for (int q4 = 0; q4 < 2; ++q4) { bf16_t tmp[8];
#pragma unroll
                for (int e = 0; e < 8; ++e) tmp[e] = lt[(q4 * 8 + e) * 520 + c];
                uint4 st; st.x = tmp[0] | ((unsigned)tmp[1] << 16); st.y = tmp[2] | ((unsigned)tmp[3] << 16); st.z = tmp[4] | ((unsigned)tmp[5] << 16); st.w = tmp[6] | ((unsigned)tmp[7] << 16);
                *(uint4*)(vnT + ((size_t)(r0 >> 7) * 512 + c) * 128 + (r0 & 127) + q4 * 8) = st; } }
        __syncthreads();
        if (l == 1) { bf16_t* hdl = lt + 8192; if (tid < 64) *(uint4*)(hdl + tid * 8) = *(const uint4*)(HDh + (size_t)rr0 * 32 + tid * 8); }
        __syncthreads();
        if (tid < 448) {
            float pv[4], cv[4], nv[4];
            { const bool ok = t0 > 0; const bf16x4 a = ok ? *(const bf16x4*)(RWh + (size_t)(rr0 - 1) * 1792 + ch) : (bf16x4){0, 0, 0, 0};
              const bf16x4 c2 = *(const bf16x4*)(RWh + (size_t)rr0 * 1792 + ch);
#pragma unroll
              for (int e = 0; e < 4; ++e) { pv[e] = bfs(a[e]); cv[e] = bfs(c2[e]); } }
            for (int bt = 0; bt < 1; ++bt) {
                bf16x4 nxt[16], vfs[16];
#pragma unroll
                for (int i = 0; i < 16; ++i) { const int ii = bt * 16 + i; const bool ok = t0 + ii + 1 < T;
                    nxt[i] = ok ? *(const bf16x4*)(RWh + (size_t)(rr0 + ii + 1) * 1792 + ch) : (bf16x4){0, 0, 0, 0};
                    vfs[i] = (l == 1 && isv) ? *(const bf16x4*)(V0 + (size_t)(hf * HROWS + rr0 + ii) * 512 + ch - 1024) : (bf16x4){0, 0, 0, 0}; }
#pragma unroll
                for (int i = 0; i < 16; ++i) {
                    const int ii = bt * 16 + i, rr = rr0 + ii, r = hf * HROWS + rr;
#pragma unroll
                    for (int e = 0; e < 4; ++e) nv[e] = bfs(nxt[i][e]);
                    float o[4];
#pragma unroll
                    for (int e = 0; e < 4; ++e) o[e] = pv[e] * cw[0][e] + cv[e] * cw[1][e] + nv[e] * cw[2][e];
                    if (tid < 128) { uint2 st; st.x = pk2(o[0], o[1]); st.y = pk2(o[2], o[3]); *(uint2*)(BIG + (size_t)r * LDB + C_RKV + ch) = st; }
                    else if (tid < 256) {
                        uint2 st; st.x = pk2(o[0], o[1]); st.y = pk2(o[2], o[3]); *(uint2*)(BIG + (size_t)r * LDB + C_RKV + ch) = st;
                        float sq = 0.f;
#pragma unroll
                        for (int e = 0; e < 4; ++e) { const float kq = o[e] * kkw[e]; sq += kq * kq; }
                        sq += __shfl_xor(sq, 1); sq += __shfl_xor(sq, 2); sq += __shfl_xor(sq, 4); sq += __shfl_xor(sq, 8);
                        if ((tid & 15) == 0) RINV[(size_t)r * 8 + ((tid - 128) >> 4)] = rsqrtf(sq + 1e-12f);
                    } else if (tid < 384) {
                        if (l == 0) { uint2 st; st.x = pk2(o[0], o[1]); st.y = pk2(o[2], o[3]); *(uint2*)(V0 + (size_t)r * 512 + ch - 1024) = st; }
                        else {
                            float z[4] = {vb[0], vb[1], vb[2], vb[3]};
                            const bf16_t* hdl = lt + 8192 + ii * 32;
#pragma unroll
                            for (int jq = 0; jq < 4; ++jq) { const bf16x8 hd = *(const bf16x8*)(hdl + jq * 8);
#pragma unroll
                                for (int j = 0; j < 8; ++j) { const float hv = bfs(hd[j]); const f32x4 uu = *(const f32x4*)(upl + (jq * 8 + j) * 512 + ch - 1024);
#pragma unroll
                                    for (int e = 0; e < 4; ++e) z[e] += hv * uu[e]; } }
#pragma unroll
                            for (int e = 0; e < 4; ++e) o[e] = o[e] + (bfs(vfs[i][e]) - o[e]) * sigm(z[e]);
                        }
                        uint2 st; st.x = pk2(o[0], o[1]); st.y = pk2(o[2], o[3]); *(uint2*)(BIG + (size_t)r * LDB + C_RKV + ch) = st;
                    } else {
                        const int ac = ch - 1536;
#pragma unroll
                        for (int e = 0; e < 4; ++e) { if (ac < 64) o[e] = 1.0f - 2.0f * __builtin_amdgcn_rcpf(1.0f + __expf(2.0f * o[e])); else if (ac >= 128) o[e] = sigm(o[e]); }
                        uint2 st; st.x = pk2(o[0], o[1]); st.y = pk2(o[2], o[3]); *(uint2*)(AL + (size_t)r * 256 + ac) = st;
                    }
#pragma unroll
                    for (int e = 0; e < 4; ++e) { pv[e] = cv[e]; cv[e] = nv[e]; }
                }
            }
        }
        __syncthreads();
    }
}

__device__ __forceinline__ void scan_block(PREF p, int l) {
    unsigned char* ws = p.ws; const int tid = ltid(), lane = tid & 63, wave = tid >> 6;
    const int s2 = lbid(), s = s2 >> 1, rhalf = s2 & 1, d = s >> 6, b = (s >> 3) & 7, h = s & 7;
    const bf16_t* BIG = (const bf16_t*)(ws + OFF_BIG); const bf16_t* AL = (const bf16_t*)(ws + OFF_AL); const float* RINV = (const float*)(ws + OFF_RINV);
    bf16_t* Y = (bf16_t*)(ws + OFF_B + B_Y) + (size_t)d * NROW * 512;
    float* stg = (float*)smem;
    const int NC = 136;
    f32x4 Sa = zf4(), Sb = zf4();
    const int rp = lane >> 3, kq = lane & 7, v0 = 32 * rhalf + 8 * (wave & 3) + rp;
    const int lt = tid - 256, lw = (lt >> 6) & 3, c16 = lane & 15, quad = lane >> 4, chn = 16 * lw + c16, chg = h * 64 + chn;
    const int sidx1 = (lt >> 3) & 31, cg8 = lt & 7;
    bf16x8 bw[2], ba[2]; float w0c = 0.f, a0c = 0.f, kkc = 0.f, kac = 0.f, kk8[8];
    {   const bf16_t* wwa = (const bf16_t*)(ws + OFF_WWA);
        for (int ks = 0; ks < 2; ++ks) { bw[ks] = *(const bf16x8*)(wwa + (size_t)((d * 2 + 0) * 512 + chg) * 64 + ks * 32 + quad * 8); ba[ks] = *(const bf16x8*)(wwa + (size_t)((d * 2 + 1) * 512 + chg) * 64 + ks * 32 + quad * 8); }
        w0c = p.rwkv_w0[(l * 2 + d) * 512 + chg]; a0c = p.rwkv_a0[(l * 2 + d) * 512 + chg]; kkc = p.rwkv_k_k[l * 512 + chg]; kac = p.rwkv_k_a[l * 512 + chg];
#pragma unroll
        for (int e = 0; e < 8; ++e) kk8[e] = p.rwkv_k_k[l * 512 + h * 64 + cg8 * 8 + e]; }
    bf16x8 Lr8, Lk8, Lv8, Lxw[2][2], Lxa[2][2]; float Lrinv = 0.f, Lri2[2][4]; bf16_t Lkf[2][4];
    auto issue = [&](int ci) {
        const int isl = ci >= 8, i0 = isl ? (ci - 8) * 32 : ci * 32, T = isl ? 4096 : 256, seg = isl ? seg_lat(b) : seg_ctx(b);
        {   const int i = i0 + sidx1, row = seg + (d ? T - 1 - i : i);
            const bf16_t* rb = BIG + (size_t)row * LDB + C_RKV + h * 64 + cg8 * 8;
            Lr8 = *(const bf16x8*)rb; Lk8 = *(const bf16x8*)(rb + 512); Lv8 = *(const bf16x8*)(rb + 1024); Lrinv = RINV[(size_t)row * 8 + h]; }
#pragma unroll
        for (int m = 0; m < 2; ++m) {
            const int iA = i0 + m * 16 + c16, rowA = seg + (d ? T - 1 - iA : iA);
#pragma unroll
            for (int ks = 0; ks < 2; ++ks) { Lxw[m][ks] = *(const bf16x8*)(AL + (size_t)rowA * 256 + ks * 32 + quad * 8); Lxa[m][ks] = *(const bf16x8*)(AL + (size_t)rowA * 256 + 64 + ks * 32 + quad * 8); }
#pragma unroll
            for (int e = 0; e < 4; ++e) { const int i = i0 + m * 16 + quad * 4 + e, row = seg + (d ? T - 1 - i : i);
                Lkf[m][e] = BIG[(size_t)row * LDB + C_RKV + 512 + chg]; Lri2[m][e] = RINV[(size_t)row * 8 + h]; }
        }
    };
    auto finish = [&](float* buf) {
        {   float* base = buf + sidx1 * 384 + cg8 * 8; f32x4 t0, t1;
#pragma unroll
            for (int e = 0; e < 4; ++e) { t0[e] = -bfs(Lk8[e]) * kk8[e] * Lrinv; t1[e] = -bfs(Lk8[4 + e]) * kk8[4 + e] * Lrinv; }
            *(f32x4*)(base) = t0; *(f32x4*)(base + 4) = t1;
#pragma unroll
            for (int e = 0; e < 4; ++e) { t0[e] = bfs(Lr8[e]); t1[e] = bfs(Lr8[4 + e]); }
            *(f32x4*)(base + 256) = t0; *(f32x4*)(base + 260) = t1;
#pragma unroll
            for (int e = 0; e < 4; ++e) { t0[e] = bfs(Lv8[e]); t1[e] = bfs(Lv8[4 + e]); }
            *(f32x4*)(base + 320) = t0; *(f32x4*)(base + 324) = t1;
        }
#pragma unroll
        for (int m = 0; m < 2; ++m) {
            f32x4 aw = zf4(), aa = zf4();
#pragma unroll
            for (int ks = 0; ks < 2; ++ks) { aw = __builtin_amdgcn_mfma_f32_16x16x32_bf16(Lxw[m][ks], bw[ks], aw, 0, 0, 0); aa = __builtin_amdgcn_mfma_f32_16x16x32_bf16(Lxa[m][ks], ba[ks], aa, 0, 0, 0); }
#pragma unroll
            for (int e = 0; e < 4; ++e) { const int si = m * 16 + quad * 4 + e;
                const float kf = bf2f(Lkf[m][e]), rinv = Lri2[m][e];
                const float dec = __expf(-0.6065306597f * sigm(w0c + aw[e])), as = sigm(a0c + aa[e]);
                float* base = buf + si * 384 + chn; base[64] = dec; base[128] = kf * (1.0f + (as - 1.0f) * kac); base[192] = kf * kkc * rinv * as; }
        }
    };
    if (wave >= 4) { issue(0); finish(stg); issue(1); }

    __syncthreads();
    for (int ci = 0; ci < NC; ++ci) {
        float* buf = stg + (ci & 1) * (32 * 384);
        if (wave < 4) {
            const int isl = ci >= 8, i0 = isl ? (ci - 8) * 32 : ci * 32, T = isl ? 4096 : 256, seg = isl ? seg_lat(b) : seg_ctx(b);
            const float* base0 = buf + kq * 8;
            f32x4 oa0, oa1, ow0, ow1, ok0, ok1, ob0, ob1, or0, or1; float ov;
            f32x4 na0, na1, nw0, nw1, nk0, nk1, nb0, nb1, nr0, nr1; float nv;
#define SC_LOAD(P, st_) do { const float* bs_ = base0 + (st_) * 384; P##a0 = *(const f32x4*)(bs_); P##a1 = *(const f32x4*)(bs_ + 4); P##w0 = *(const f32x4*)(bs_ + 64); P##w1 = *(const f32x4*)(bs_ + 68); \
                P##k0 = *(const f32x4*)(bs_ + 128); P##k1 = *(const f32x4*)(bs_ + 132); P##b0 = *(const f32x4*)(bs_ + 192); P##b1 = *(const f32x4*)(bs_ + 196); \
                P##r0 = *(const f32x4*)(bs_ + 256); P##r1 = *(const f32x4*)(bs_ + 260); P##v = buf[(st_) * 384 + 320 + v0]; } while (0)
#define SC_STEP(P, st_) do { f32x4 t_ = Sa * P##a0 + Sb * P##a1; float sa_ = (t_[0] + t_[1]) + (t_[2] + t_[3]); sa_ = red8(sa_); \
                Sa = Sa * P##w0 + (P##b0 * sa_ + P##k0 * P##v); Sb = Sb * P##w1 + (P##b1 * sa_ + P##k1 * P##v); \
                f32x4 u_ = Sa * P##r0 + Sb * P##r1; float y_ = (u_[0] + u_[1]) + (u_[2] + u_[3]); y_ = red8(y_); \
                if (kq == 0) { const int i_ = i0 + (st_), row_ = seg + (d ? T - 1 - i_ : i_); Y[(size_t)row_ * 512 + h * 64 + v0] = f2bf(y_); } } while (0)
            SC_LOAD(o, 0);
            for (int st = 0; st < 32; st += 2) {
                SC_LOAD(n, st + 1);
                SC_STEP(o, st);
                if (st + 2 < 32) SC_LOAD(o, st + 2);
                SC_STEP(n, st + 1);
            }
#undef SC_LOAD
#undef SC_STEP
        } else if (ci + 1 < NC) { finish(stg + ((ci + 1) & 1) * (32 * 384)); if (ci + 2 < NC) issue(ci + 2); }
        __syncthreads();
    }
}

#define MF16(a, b, c) __builtin_amdgcn_mfma_f32_16x16x16bf16_1k(a, b, c, 0, 0, 0)
#define LDS_SYNC() asm volatile("s_waitcnt lgkmcnt(0)" ::: "memory")
__device__ __forceinline__ bf16x4 pk4(f32x4 v) { u32x2 r; r[0] = cvtpk(v[0], v[1]); r[1] = cvtpk(v[2], v[3]); return __builtin_bit_cast(bf16x4, r); }
__device__ __forceinline__ f32x4 mm16(const bf16_t* A, int lda, const bf16_t* B, int ldb, int K, f32x4 acc, int c16, int quad) {
    for (int kk = 0; kk < K; kk += 16) { const bf16x4 a = *(const bf16x4*)(A + c16 * lda + kk + quad * 4), b = *(const bf16x4*)(B + c16 * ldb + kk + quad * 4); acc = MF16(a, b, acc); }
    return acc;
}
constexpr int SC_PS = 68, SC_M = 16 * SC_PS, SC_SLOT = 11776, SC_SCR = 10752, SC_NL = 4, SC_NCH = 272;
__device__ __forceinline__ void scan_chunked(PREF p, int l) {
    unsigned char* ws = p.ws; const int tid = ltid(), lane = tid & 63, wave = tid >> 6, c16 = lane & 15, quad = lane >> 4;
    const int s = lbid(), d = s >> 6, b = (s >> 3) & 7, h = s & 7;
    const bf16_t* BIG = (const bf16_t*)(ws + OFF_BIG); const bf16_t* AL = (const bf16_t*)(ws + OFF_AL); const float* RINV = (const float*)(ws + OFF_RINV);
    bf16_t* Y = (bf16_t*)(ws + OFF_B + B_Y) + (size_t)d * NROW * 512;
    unsigned char* slots = smem; unsigned char* scr = smem + 2 * SC_NL * SC_SLOT + ((wave >= 2 && wave < 2 + SC_NL) ? (wave - 2) : 0) * SC_SCR;
    bf16_t* AH = (bf16_t*)scr; bf16_t* RH = AH + SC_M; bf16_t* BC = RH + SC_M; bf16_t* KC = BC + SC_M; bf16_t* AHT = KC + SC_M; float* LF = (float*)BC;
    bf16_t* TB = KC; bf16_t* AKT = TB + 256; bf16_t* ARB = AKT + 256;
    bf16_t* WL = (bf16_t*)(smem + 2 * SC_NL * SC_SLOT + SC_NL * SC_SCR);
    {   const bf16_t* wwa = (const bf16_t*)(ws + OFF_WWA);
        for (int i = tid; i < 1024; i += 512) { const int wa = i >> 9, ch = (i >> 3) & 63, q8 = i & 7;
            *(uint4*)(WL + ((wa * 64 + ch) * 72 + q8 * 8)) = *(const uint4*)(wwa + (size_t)((d * 2 + wa) * 512 + h * 64 + ch) * 64 + q8 * 8); } }
    bf16x4 Pr[4], Pk[4]; bf16x8 Pxw[2], Pxa[2], Pv[2]; float Prinv = 0.f;
    auto rowof = [&](int c, int tk) -> int { const int isl = c >= 16, i = (isl ? (c - 16) * 16 : c * 16) + tk, T = isl ? 4096 : 256; return (isl ? seg_lat(b) : seg_ctx(b)) + (d ? T - 1 - i : i); };
    auto issue = [&](int c) {
        const int row = rowof(c, c16); const bf16_t* rb = BIG + (size_t)row * LDB + C_RKV + h * 64 + quad * 4;
#pragma unroll
        for (int nt = 0; nt < 4; ++nt) { Pr[nt] = *(const bf16x4*)(rb + nt * 16); Pk[nt] = *(const bf16x4*)(rb + 512 + nt * 16); }
        Prinv = RINV[(size_t)row * 8 + h];
#pragma unroll
        for (int ks = 0; ks < 2; ++ks) { Pxw[ks] = *(const bf16x8*)(AL + (size_t)row * 256 + ks * 32 + quad * 8); Pxa[ks] = *(const bf16x8*)(AL + (size_t)row * 256 + 64 + ks * 32 + quad * 8); }
        { const bf16_t* vp = BIG + (size_t)rowof(c, lane >> 2) * LDB + C_RKV + 1024 + h * 64 + (lane & 3) * 16; Pv[0] = *(const bf16x8*)vp; Pv[1] = *(const bf16x8*)(vp + 8); }
    };
    auto build = [&](unsigned char* slot) {
        bf16_t* sW1 = (bf16_t*)slot; bf16_t* sQ1 = sW1 + SC_M; bf16_t* sA2 = sQ1 + SC_M; bf16_t* sA3 = sA2 + 256; bf16_t* sBT = sA3 + 256; bf16_t* sKT = sBT + 1024; float* sG = (float*)(sKT + 1024); bf16_t* sVT = (bf16_t*)(sG + 64);
#pragma unroll
        for (int e = 0; e < 8; ++e) { sVT[((lane & 3) * 16 + e) * 16 + (lane >> 2)] = (bf16_t)Pv[0][e]; sVT[((lane & 3) * 16 + 8 + e) * 16 + (lane >> 2)] = (bf16_t)Pv[1][e]; }
#pragma unroll
        for (int nt = 0; nt < 4; ++nt) {
            f32x4 aw = zf4(), aa = zf4();
#pragma unroll
            for (int ks = 0; ks < 2; ++ks) { const bf16x8 fw = *(const bf16x8*)(WL + ((nt * 16 + c16) * 72 + ks * 32 + quad * 8)), fa = *(const bf16x8*)(WL + ((64 + nt * 16 + c16) * 72 + ks * 32 + quad * 8));
                aw = __builtin_amdgcn_mfma_f32_16x16x32_bf16(fw, Pxw[ks], aw, 0, 0, 0); aa = __builtin_amdgcn_mfma_f32_16x16x32_bf16(fa, Pxa[ks], aa, 0, 0, 0); }
            const int ch0 = nt * 16 + quad * 4, cg = h * 64 + ch0;
            const f32x4 w0v = *(const f32x4*)(p.rwkv_w0 + (l * 2 + d) * 512 + cg), a0v = *(const f32x4*)(p.rwkv_a0 + (l * 2 + d) * 512 + cg), kkv = *(const f32x4*)(p.rwkv_k_k + l * 512 + cg), kav = *(const f32x4*)(p.rwkv_k_a + l * 512 + cg);
            f32x4 vAH, vRH, vBC, vKC;
#pragma unroll
            for (int e = 0; e < 4; ++e) {
                const float lw = -0.6065306597f * sigm(w0v[e] + aw[e]);
                float g = lw;
                g += __int_as_float(__builtin_amdgcn_update_dpp(0, __float_as_int(g), 0x111, 0xF, 0xF, true));
                g += __int_as_float(__builtin_amdgcn_update_dpp(0, __float_as_int(g), 0x112, 0xF, 0xF, true));
                g += __int_as_float(__builtin_amdgcn_update_dpp(0, __float_as_int(g), 0x114, 0xF, 0xF, true));
                g += __int_as_float(__builtin_amdgcn_update_dpp(0, __float_as_int(g), 0x118, 0xF, 0xF, true));
                const float g15 = __shfl(g, (lane & 48) | 15), gm1 = g - lw;
                const float as = sigm(a0v[e] + aa[e]), kf = bfs(Pk[nt][e]), rf = bfs(Pr[nt][e]), kk = kf * kkv[e] * Prinv;
                const float bv = kk * as, kd = kf * (1.0f + (as - 1.0f) * kav[e]);
                const float eg = __expf(g), egm1 = __expf(gm1), eng = __expf(-g), etl = __expf(g15 - g);
                vAH[e] = -kk * egm1; vRH[e] = rf * eg; vBC[e] = bv * eng; vKC[e] = kd * eng;
                AHT[(ch0 + e) * 16 + c16] = f2bf(vAH[e]); sBT[(ch0 + e) * 16 + c16] = f2bf(bv * etl); sKT[(ch0 + e) * 16 + c16] = f2bf(kd * etl);
                if (c16 == 15) sG[ch0 + e] = eg;
            }
            *(bf16x4*)(AH + c16 * SC_PS + ch0) = pk4(vAH); *(bf16x4*)(RH + c16 * SC_PS + ch0) = pk4(vRH); *(bf16x4*)(BC + c16 * SC_PS + ch0) = pk4(vBC); *(bf16x4*)(KC + c16 * SC_PS + ch0) = pk4(vKC);
        }
        LDS_SYNC();
        f32x4 Lab = mm16(BC, SC_PS, AH, SC_PS, 64, zf4(), c16, quad);
        f32x4 Lak = mm16(AH, SC_PS, KC, SC_PS, 64, zf4(), c16, quad);
        f32x4 Lrb = mm16(BC, SC_PS, RH, SC_PS, 64, zf4(), c16, quad);
        f32x4 Lrk = mm16(KC, SC_PS, RH, SC_PS, 64, zf4(), c16, quad);
        LDS_SYNC();
#pragma unroll
        for (int e = 0; e < 4; ++e) { const int tq = quad * 4 + e; if (!(tq < c16)) Lab[e] = 0.f; if (!(c16 < tq)) Lak[e] = 0.f; if (!(tq <= c16)) { Lrb[e] = 0.f; Lrk[e] = 0.f; } }
        *(f32x4*)(LF + c16 * 16 + quad * 4) = Lab;
        *(bf16x4*)(AKT + c16 * 16 + quad * 4) = pk4(Lak);
        *(bf16x4*)(ARB + c16 * 16 + quad * 4) = pk4(Lrb);
        LDS_SYNC();
        {   float Tc[16];
#pragma unroll
            for (int i = 0; i < 16; ++i) { float acc0 = (i == c16) ? 1.0f : 0.0f, acc1 = 0.f;
                f32x4 lv[4];
#pragma unroll
                for (int s4 = 0; s4 < 4; ++s4) lv[s4] = (s4 * 4 < i) ? *(const f32x4*)(LF + i * 16 + s4 * 4) : (f32x4){0.f, 0.f, 0.f, 0.f};
#pragma unroll
                for (int sI = 0; sI < 16; ++sI) { if (sI < i) { if (sI & 1) acc1 += lv[sI >> 2][sI & 3] * Tc[sI]; else acc0 += lv[sI >> 2][sI & 3] * Tc[sI]; } }
                Tc[i] = acc0 + acc1; }
            if (quad == 0) {
#pragma unroll
                for (int i = 0; i < 16; ++i) TB[i * 16 + c16] = f2bf(Tc[i]); }
        }
        LDS_SYNC();
        const bf16x4 arb = *(const bf16x4*)(ARB + c16 * 16 + quad * 4);
#pragma unroll
        for (int nt = 0; nt < 4; ++nt) {
            const f32x4 w1b = mm16(AHT + nt * 256, 16, TB, 16, 16, zf4(), c16, quad);
            *(bf16x4*)(sW1 + c16 * SC_PS + nt * 16 + quad * 4) = pk4(w1b);
            const bf16x4 w1a = pk4(mm16(TB, 16, AHT + nt * 256, 16, 16, zf4(), c16, quad));
            const bf16x4 rh = *(const bf16x4*)(RH + c16 * SC_PS + nt * 16 + quad * 4); f32x4 q1;
#pragma unroll
            for (int e = 0; e < 4; ++e) q1[e] = bfs(rh[e]);
            q1 = MF16(w1a, arb, q1);
            *(bf16x4*)(sQ1 + c16 * SC_PS + nt * 16 + quad * 4) = pk4(q1);
        }
        {   const bf16x4 a2a = pk4(mm16(TB, 16, AKT, 16, 16, zf4(), c16, quad));
            const f32x4 a2b = mm16(AKT, 16, TB, 16, 16, zf4(), c16, quad);
            *(bf16x4*)(sA2 + c16 * 16 + quad * 4) = pk4(a2b);
            const f32x4 a3 = MF16(a2a, arb, Lrk);
            *(bf16x4*)(sA3 + c16 * 16 + quad * 4) = pk4(a3); }
        LDS_SYNC();
    };
    f32x4 Hc[2][4];
#pragma unroll
    for (int sl = 0; sl < 2; ++sl)
#pragma unroll
        for (int kt = 0; kt < 4; ++kt) Hc[sl][kt] = zf4();
    auto consume = [&](int c, const unsigned char* slot) {
        const bf16_t* sW1 = (const bf16_t*)slot; const bf16_t* sQ1 = sW1 + SC_M; const bf16_t* sA2 = sQ1 + SC_M; const bf16_t* sA3 = sA2 + 256; const bf16_t* sBT = sA3 + 256; const bf16_t* sKT = sBT + 1024; const float* sG = (const float*)(sKT + 1024); const bf16_t* sVT = (const bf16_t*)(sG + 64);
        bf16x4 vb[2]; f32x4 aU[2], aY[2];
#pragma unroll
        for (int sl = 0; sl < 2; ++sl) { vb[sl] = *(const bf16x4*)(sVT + (32 * wave + 16 * sl + c16) * 16 + quad * 4); aU[sl] = zf4(); aY[sl] = zf4(); }
#pragma unroll
        for (int kt = 0; kt < 4; ++kt) { const bf16x4 w1f = *(const bf16x4*)(sW1 + c16 * SC_PS + kt * 16 + quad * 4), q1f = *(const bf16x4*)(sQ1 + c16 * SC_PS + kt * 16 + quad * 4);
#pragma unroll
            for (int sl = 0; sl < 2; ++sl) { const bf16x4 hb = pk4(Hc[sl][kt]); aU[sl] = MF16(w1f, hb, aU[sl]); aY[sl] = MF16(q1f, hb, aY[sl]); } }
        { const bf16x4 a2f = *(const bf16x4*)(sA2 + c16 * 16 + quad * 4), a3f = *(const bf16x4*)(sA3 + c16 * 16 + quad * 4);
#pragma unroll
          for (int sl = 0; sl < 2; ++sl) { aU[sl] = MF16(a2f, vb[sl], aU[sl]); aY[sl] = MF16(a3f, vb[sl], aY[sl]); } }
        bf16x4 ub[2];
#pragma unroll
        for (int sl = 0; sl < 2; ++sl) ub[sl] = pk4(aU[sl]);
#pragma unroll
        for (int kt = 0; kt < 4; ++kt) { const f32x4 gm = *(const f32x4*)(sG + kt * 16 + quad * 4);
            const bf16x4 bf = *(const bf16x4*)(sBT + (kt * 16 + c16) * 16 + quad * 4), kf = *(const bf16x4*)(sKT + (kt * 16 + c16) * 16 + quad * 4);
#pragma unroll
            for (int sl = 0; sl < 2; ++sl) { f32x4 hn = Hc[sl][kt] * gm; hn = MF16(bf, ub[sl], hn); hn = MF16(kf, vb[sl], hn); Hc[sl][kt] = hn; } }
#pragma unroll
        for (int e = 0; e < 4; ++e) { bf16_t* yp = Y + (size_t)rowof(c, quad * 4 + e) * 512 + h * 64 + 32 * wave + c16; yp[0] = f2bf(aY[0][e]); yp[16] = f2bf(aY[1][e]); }
    };
    const int NR = (SC_NCH + SC_NL - 1) / SC_NL;
    const bool isload = wave >= 2 && wave < 2 + SC_NL, iscomp = wave < 2;
    if (isload) issue(wave - 2);
    __syncthreads();
    for (int R = 0; R <= NR; ++R) {
        if (isload) { const int c = R * SC_NL + (wave - 2); if (c < SC_NCH) { build(slots + ((R & 1) * SC_NL + (wave - 2)) * SC_SLOT); if (c + SC_NL < SC_NCH) issue(c + SC_NL); } }
        else if (iscomp && R > 0) { for (int q = 0; q < SC_NL; ++q) { const int c = (R - 1) * SC_NL + q; if (c < SC_NCH) consume(c, slots + (((R - 1) & 1) * SC_NL + q) * SC_SLOT); } }
        __syncthreads();
    }
}

__device__ __forceinline__ void attn_item(PREF p, int l, int item) {
    unsigned char* ws = p.ws; const int tid = ltid(), lane = tid & 63, wave = tid >> 6, g = wave >> 1, hq = wave & 1, quad = lane >> 4, c16 = lane & 15;
    bf16_t* BIG = (bf16_t*)(ws + OFF_BIG); const bf16_t* vTl = (const bf16_t*)(ws + OFF_VT); const bf16_t* vTc = vTl + (size_t)8 * 128 * 4096;
    int b, qb = 0, kvh, q0, qrow0; bool latent;
    if (item < 512) { latent = true; b = item >> 6; qb = (item >> 1) & 31; kvh = item & 1; q0 = qb * 128 + 64 * hq; qrow0 = seg_lat(b) + q0; }
    else { const int it2 = item - 512; latent = false; b = it2 >> 2; kvh = (it2 >> 1) & 1; q0 = (it2 & 1) * 128 + 64 * hq; qrow0 = seg_ctx(b) + q0; }
    const int head = kvh * 4 + g; const float sink = p.attn_sink[l * 8 + head];
    int jlo = 0, nband = 0;
    if (latent) { jlo = hq > (qb == 0 ? 2 : 0) ? hq : (qb == 0 ? 2 : 0); const int jhi = (hq + 4) < (qb == 31 ? 3 : 5) ? (hq + 4) : (qb == 31 ? 3 : 5); nband = jhi - jlo + 1; }
    const int nblk = nband + 4;
    auto blk_k = [&](int i) -> const bf16_t* {
        const int krow0 = i < nband ? seg_lat(b) + qb * 128 - 128 + 64 * (jlo + i) : seg_ctx(b) + 64 * (i - nband);
        return BIG + (size_t)(krow0 + c16) * LDB + 512 + kvh * 64 + quad * 8; };
    auto blk_v = [&](int i) -> const bf16_t* {
        const bf16_t* vt = i < nband ? vTl + (size_t)((b * 2 + kvh) * 64 + ((qb * 128 - 128 + 64 * (jlo + i)) >> 6)) * 4096 : vTc + (size_t)((b * 2 + kvh) * 4 + (i - nband)) * 4096;
        return vt + c16 * 64 + quad * 4; };
    for (int qh = 0; qh < 2; ++qh) {
    const int qr = qrow0 + qh * 32, qq = q0 + qh * 32;
    bf16x8 qf[2][2];
#pragma unroll
    for (int qt = 0; qt < 2; ++qt)
#pragma unroll
        for (int ks = 0; ks < 2; ++ks) qf[qt][ks] = *(const bf16x8*)(BIG + (size_t)(qr + qt * 16 + c16) * LDB + head * 64 + ks * 32 + quad * 8);
    f32x4 o[4][2]; float mx[2], ls[2];
#pragma unroll
    for (int qt = 0; qt < 2; ++qt) { mx[qt] = sink; ls[qt] = quad == 0 ? 1.0f : 0.0f;
#pragma unroll
        for (int dt = 0; dt < 4; ++dt) o[dt][qt] = zf4(); }
    bf16x8 kf[4][2];
    { const bf16_t* kp = blk_k(0);
#pragma unroll
      for (int kt = 0; kt < 4; ++kt) { kf[kt][0] = *(const bf16x8*)(kp + (size_t)kt * 16 * LDB); kf[kt][1] = *(const bf16x8*)(kp + (size_t)kt * 16 * LDB + 32); } }
    for (int blk = 0; blk < nblk; ++blk) {
        const bool band = blk < nband; const int kp0 = qb * 128 - 128 + 64 * (jlo + blk);
        bf16x4 va[2][4], vb[2][4];
        { const bf16_t* vp = blk_v(blk);
#pragma unroll
          for (int kp2 = 0; kp2 < 2; ++kp2)
#pragma unroll
            for (int dt = 0; dt < 4; ++dt) { va[kp2][dt] = *(const bf16x4*)(vp + dt * 16 * 64 + kp2 * 32); vb[kp2][dt] = *(const bf16x4*)(vp + dt * 16 * 64 + kp2 * 32 + 16); } }
        f32x4 s[4][2];
#pragma unroll
        for (int kt = 0; kt < 4; ++kt)
#pragma unroll
            for (int qt = 0; qt < 2; ++qt) { f32x4 a = zf4(); a = __builtin_amdgcn_mfma_f32_16x16x32_bf16(kf[kt][0], qf[qt][0], a, 0, 0, 0); a = __builtin_amdgcn_mfma_f32_16x16x32_bf16(kf[kt][1], qf[qt][1], a, 0, 0, 0); s[kt][qt] = a; }
        if (blk + 1 < nblk) { const bf16_t* kp = blk_k(blk + 1);
#pragma unroll
            for (int kt = 0; kt < 4; ++kt) { kf[kt][0] = *(const bf16x8*)(kp + (size_t)kt * 16 * LDB); kf[kt][1] = *(const bf16x8*)(kp + (size_t)kt * 16 * LDB + 32); } }
        if (band) {
#pragma unroll
            for (int kt = 0; kt < 4; ++kt)
#pragma unroll
                for (int qt = 0; qt < 2; ++qt)
#pragma unroll
                    for (int e = 0; e < 4; ++e) { const int dl = (kp0 + kt * 16 + quad * 4 + e) - (qq + qt * 16 + c16); if (dl > 128 || dl < -128) s[kt][qt][e] = -1e30f; }
        }
#pragma unroll
        for (int qt = 0; qt < 2; ++qt) {
            float m2 = s[0][qt][0];
#pragma unroll
            for (int kt = 0; kt < 4; ++kt)
#pragma unroll
                for (int e = 0; e < 4; ++e) m2 = fmaxf(m2, s[kt][qt][e]);
            m2 = fmaxf(m2, __shfl_xor(m2, 16)); m2 = fmaxf(m2, __shfl_xor(m2, 32));
            const float mn = fmaxf(mx[qt], m2), al = __expf(mx[qt] - mn); mx[qt] = mn; float lsum = ls[qt] * al;
#pragma unroll
            for (int dt = 0; dt < 4; ++dt) o[dt][qt] *= al;
#pragma unroll
            for (int kt = 0; kt < 4; ++kt)
#pragma unroll
                for (int e = 0; e < 4; ++e) { const float pe = __expf(s[kt][qt][e] - mn); lsum += pe; s[kt][qt][e] = pe; }
            ls[qt] = lsum;
        }
#pragma unroll
        for (int kp2 = 0; kp2 < 2; ++kp2) {
            bf16x8 pb[2];
#pragma unroll
            for (int qt = 0; qt < 2; ++qt)
#pragma unroll
                for (int e = 0; e < 4; ++e) { pb[qt][e] = (short)f2bf(s[2 * kp2][qt][e]); pb[qt][4 + e] = (short)f2bf(s[2 * kp2 + 1][qt][e]); }
#pragma unroll
            for (int dt = 0; dt < 4; ++dt) {
                bf16x8 vf; vf[0] = va[kp2][dt][0]; vf[1] = va[kp2][dt][1]; vf[2] = va[kp2][dt][2]; vf[3] = va[kp2][dt][3]; vf[4] = vb[kp2][dt][0]; vf[5] = vb[kp2][dt][1]; vf[6] = vb[kp2][dt][2]; vf[7] = vb[kp2][dt][3];
#pragma unroll
                for (int qt = 0; qt < 2; ++qt) o[dt][qt] = __builtin_amdgcn_mfma_f32_16x16x32_bf16(vf, pb[qt], o[dt][qt], 0, 0, 0);
            }
        }
    }
#pragma unroll
    for (int qt = 0; qt < 2; ++qt) {
        float lt = ls[qt]; lt += __shfl_xor(lt, 16); lt += __shfl_xor(lt, 32); const float inv = __builtin_amdgcn_rcpf(lt);
#pragma unroll
        for (int dt = 0; dt < 4; ++dt) st_bf4(BIG + (size_t)(qr + qt * 16 + c16) * LDB + head * 64 + dt * 16 + quad * 4, o[dt][qt] * inv);
    }
    }
}

__device__ __forceinline__ void sgu_tile(PREF p, int l, int tile) {
    unsigned char* ws = p.ws; const int tid = ltid(), lane = tid & 63, w = tid >> 6, quad = lane >> 4, c16 = lane & 15;
    const int n = tile >> 2, g = tile & 3, row0 = n * 128;
    bf16_t* BIG = (bf16_t*)(ws + OFF_BIG); const bf16_t* vnT = (const bf16_t*)(ws + OFF_VNT); const bf16_t* wsg = (const bf16_t*)(ws + OFF_WSGU);
    f32x4 acc[8];
#pragma unroll
    for (int i = 0; i < 8; ++i) acc[i] = zf4();
    const bf16_t* ap = wsg + (size_t)((g * 128 + 16 * w + c16) * 128) + quad * 8;
    const bf16_t* bp = vnT + ((size_t)n * 512 + g * 128 + c16) * 128 + quad * 8;
    bf16x8 afr[4], bcur[8], bnxt[8];
#pragma unroll
    for (int ks = 0; ks < 4; ++ks) afr[ks] = *(const bf16x8*)(ap + ks * 32);
#pragma unroll
    for (int nt = 0; nt < 8; ++nt) bcur[nt] = *(const bf16x8*)(bp + (size_t)nt * 16 * 128);
    const int pl0 = 16 * w + c16;
    bf16x4 olds[8];
#pragma unroll
    for (int nt = 0; nt < 8; ++nt) olds[nt] = *(const bf16x4*)(BIG + (size_t)(row0 + pl0) * LDB + C_SGU + g * 128 + nt * 16 + quad * 4);
#pragma unroll
    for (int ks = 0; ks < 4; ++ks) {
        if (ks < 3) {
#pragma unroll
            for (int nt = 0; nt < 8; ++nt) bnxt[nt] = *(const bf16x8*)(bp + (size_t)nt * 16 * 128 + (ks + 1) * 32); }
#pragma unroll
        for (int nt = 0; nt < 8; ++nt) acc[nt] = __builtin_amdgcn_mfma_f32_16x16x32_bf16(bcur[nt], afr[ks], acc[nt], 0, 0, 0);
#pragma unroll
        for (int nt = 0; nt < 8; ++nt) bcur[nt] = bnxt[nt];
    }
    const int pl = 16 * w + c16; const float bias = p.sgu_b[l * 512 + g * 128 + pl];
#pragma unroll
    for (int nt = 0; nt < 8; ++nt) { bf16_t* q = BIG + (size_t)(row0 + pl) * LDB + C_SGU + g * 128 + nt * 16 + quad * 4; const bf16x4 old = olds[nt]; f32x4 v;
#pragma unroll
        for (int e = 0; e < 4; ++e) v[e] = bfs(old[e]) * (acc[nt][e] + bias);
        st_bf4(q, v); }
}
__device__ __forceinline__ void phase_attn(PREF p, int l) {
    const int nb = gridDim.x - 128, bid = lbid() - 128; const int nAttn = l == 1 ? 512 : 544;
    for (int it = bid; it < nAttn; it += nb) attn_item(p, l, it);
}
__device__ __forceinline__ void phase_sgu(PREF p, int l) {
    const int nb = gridDim.x - 128, bid = (lbid() - 128 + 64) & 127; const bool last = l == 1;
    for (int tile = bid; tile < 1088; tile += nb) { const int n = tile >> 2; if (last && ((n * 128) % HROWS) >= 16384) continue; sgu_tile(p, l, tile); }
}

__device__ __forceinline__ void phase_post(PREF p, int l) {
    unsigned char* ws = p.ws; const int lane = ltid() & 63, gw = lbid() * 8 + (ltid() >> 6); const bool last = l == 1;
    bf16_t* BIG = (bf16_t*)(ws + OFF_BIG); const bf16_t* Gb = (const bf16_t*)(ws + OFF_B + B_G); const bf16_t* AS = (const bf16_t*)(ws + OFF_B + B_ASUM);
    const bf16_t* Y0 = (const bf16_t*)(ws + OFF_B + B_Y); const bf16_t* Y1 = Y0 + (size_t)NROW * 512;
    const int c = lane * 8;
    float lw[8], lb[8], rk[8], ka[8];
#pragma unroll
    for (int e = 0; e < 8; ++e) { lw[e] = p.rwkv_ln_w[l * 512 + c + e]; lb[e] = p.rwkv_ln_b[l * 512 + c + e]; rk[e] = p.rwkv_r_k[l * 512 + c + e]; ka[e] = p.rwkv_k_a[l * 512 + c + e]; }
    const int nw = gridDim.x * 8;
    for (int rb0 = gw; rb0 < NROW; rb0 += 4 * nw) {
        bf16x8 y0s[4], y1s[4], ggs[4], ass[4], r8s[4], k8s[4], v8s[4]; bool act[4];
#pragma unroll
        for (int k = 0; k < 4; ++k) { int r = rb0 + k * nw; act[k] = r < NROW && !(last && (r % HROWS) >= 16384); if (!act[k]) r = rb0;
            y0s[k] = *(const bf16x8*)(Y0 + (size_t)r * 512 + c); y1s[k] = *(const bf16x8*)(Y1 + (size_t)r * 512 + c); ggs[k] = *(const bf16x8*)(Gb + (size_t)r * 512 + c); ass[k] = *(const bf16x8*)(AS + (size_t)r * 512 + c);
            const bf16_t* rb = BIG + (size_t)r * LDB + C_RKV + c; r8s[k] = *(const bf16x8*)rb; k8s[k] = *(const bf16x8*)(rb + 512); v8s[k] = *(const bf16x8*)(rb + 1024); }
#pragma unroll
        for (int k = 0; k < 4; ++k) {
            const int r = rb0 + k * nw;
            const bf16x8 y0 = y0s[k], y1 = y1s[k], gg = ggs[k], as = ass[k], r8 = r8s[k], k8 = k8s[k], v8 = v8s[k];
            float y[8], s1 = 0.f, bo = 0.f;
#pragma unroll
            for (int e = 0; e < 8; ++e) { y[e] = bfs(y0[e]) + bfs(y1[e]); s1 += y[e]; bo += bfs(r8[e]) * bfs(k8[e]) * rk[e] * (2.0f + (bfs(as[e]) - 2.0f) * ka[e]); }
            s1 += __shfl_xor(s1, 1); s1 += __shfl_xor(s1, 2); s1 += __shfl_xor(s1, 4);
            bo += __shfl_xor(bo, 1); bo += __shfl_xor(bo, 2); bo += __shfl_xor(bo, 4);
            const float mu = s1 * (1.0f / 64.0f); float s2 = 0.f;
#pragma unroll
            for (int e = 0; e < 8; ++e) { y[e] -= mu; s2 += y[e] * y[e]; }
            s2 += __shfl_xor(s2, 1); s2 += __shfl_xor(s2, 2); s2 += __shfl_xor(s2, 4);
            const float rstd = rsqrtf(s2 * (1.0f / 64.0f) + 64e-5f);
            float o[8];
#pragma unroll
            for (int e = 0; e < 8; ++e) o[e] = (y[e] * rstd * lw[e] + lb[e] + bo * bfs(v8[e])) * bfs(gg[e]);
            uint4 st; st.x = pk2(o[0], o[1]); st.y = pk2(o[2], o[3]); st.z = pk2(o[4], o[5]); st.w = pk2(o[6], o[7]);
            if (act[k]) *(uint4*)(BIG + (size_t)r * LDB + C_RKV + c) = st;
        }
    }
}

#define KP (*kargs())
#ifndef PROBE_ID
#define PROBE_ID -1
#endif
#ifndef PROBE_L
#define PROBE_L 0
#endif
#define TS(k) do { if (PROBE_ID >= 0 && l == PROBE_L) { if ((k) == PROBE_ID) tA = wall_clock64(); if ((k) == PROBE_ID + 1) tB = wall_clock64(); } } while (0)
__global__ __launch_bounds__(512) void mega(P pdummy) {
    cg::grid_group grid = cg::this_grid();
    LAS unsigned char* lds = (LAS unsigned char*)smem;
    unsigned long long tA = 0, tB = 0;
    for (int l = 0; l < 2; ++l) {
        const bool last = l == 1;
        TS(0);
        phase_W(KP, l); grid.sync(); TS(1);
        { unsigned char* ws = kargs()->ws; phase_norm(KP, l, 0, 0, HROWS, (bf16_t*)(ws + OFF_B + B_HH), l == 0, false); } grid.sync();
        for (int hf = 0; hf < 2; ++hf) {
            {   unsigned char* ws = kargs()->ws;
                Gemm g; g.A = (const bf16_t*)(ws + OFF_B + B_HH); g.Bt = (const bf16_t*)(ws + OFF_WIN1); g.lda = 1024; g.ldb = 1024; g.K = 1024; g.perm = true;
                SchedStd S; S.init(68, last ? 15 : 14, 0);
                EpiIn E; E.qkv = (bf16_t*)(ws + OFF_B + B_QKV); E.rw = (bf16_t*)(ws + OFF_B + B_RW); E.sg = (bf16_t*)(ws + OFF_B + B_SG); E.hd = (bf16_t*)(ws + OFF_B + B_HD);
                gemm_phase(lds, g, S, E); }
            grid.sync();
            phase_prep(KP, l, hf);
            if (hf == 0) { unsigned char* ws = kargs()->ws; phase_norm(KP, l, 0, HROWS, HROWS, (bf16_t*)(ws + OFF_B + B_HH), l == 0, false); }
            grid.sync();
        }
        TS(2);
        TS(3);
        if (lbid() < 128) { scan_chunked(KP, l); __syncthreads(); TS(4);
            unsigned char* ws = kargs()->ws;
            Gemm g; g.A = (const bf16_t*)(ws + OFF_AL); g.Bt = (const bf16_t*)(ws + OFF_WGL); g.lda = 256; g.ldb = 256; g.K = 256; g.perm = true;
            SchedStd S; S.init_sub(136, 2, 128, lbid()); EpiPlain E; E.o = (bf16_t*)(ws + OFF_B + B_G); E.ld = 512; E.act = 0; gemm_phase(lds, g, S, E); }
        else { TS(30); phase_attn(KP, l); TS(31); phase_sgu(KP, l); TS(32);
            unsigned char* ws = kargs()->ws;
            Gemm g; g.A = (const bf16_t*)(ws + OFF_AL); g.Bt = (const bf16_t*)(ws + OFF_WGL) + 512 * 256; g.lda = 256; g.ldb = 256; g.K = 256; g.perm = true;
            SchedStd S; S.init_sub(136, 4, 128, (lbid() - 128 + 96) & 127); EpiAsum E; E.asum = (bf16_t*)(ws + OFF_B + B_ASUM); E.a0 = kargs()->rwkv_a0 + l * 1024; gemm_phase(lds, g, S, E); }
        TS(5); grid.sync(); TS(6);
        phase_post(KP, l); grid.sync(); TS(7);
        { unsigned char* ws = kargs()->ws; phase_norm(KP, l, 0, 0, NROW, (bf16_t*)(ws + OFF_B + B_HH), l == 0, last); } grid.sync();
        {   unsigned char* ws = kargs()->ws;
            GemmGM g; g.H = (const bf16_t*)(ws + OFF_B + B_HH); g.Wg = (const bf16_t*)(ws + OFF_WGATE); g.BIGp = (const bf16_t*)(ws + OFF_BIG); g.Wo = (const bf16_t*)(ws + OFF_WO3);
            SchedGM S; S.init(last ? 512 : 544, last ? 1 : 0);
            EpiGM E; E.scr = (bf16_t*)(ws + OFF_B + 71303168) + (size_t)lbid() * 65536; E.M = (bf16_t*)(ws + OFF_M);
            gemm_phase(lds, g, S, E); }
        grid.sync();
        TS(8);
        {   CP* kp = kargs(); unsigned char* ws = kp->ws;
            Gemm g; g.A = (const bf16_t*)(ws + OFF_M); g.Bt = (const bf16_t*)(ws + OFF_WOUT); g.lda = 1024; g.ldb = 1024; g.K = 1024; g.perm = false;
            SchedStd S; S.init(last ? 128 : 136, 4, last ? 1 : 0);
            EpiRes E; E.gmod = (const float*)(ws + OFF_MOD) + (size_t)l * 9 * 6144 + 2 * 1024; E.xo = kp->out; E.co = (float*)(ws + OFF_XSC); E.xin = l == 0 ? kp->x : (const float*)E.xo; E.cin = l == 0 ? kp->ctx : (const float*)E.co; E.readInput = l == 0;
            gemm_phase(lds, g, S, E); }
        grid.sync(); TS(9);
        { unsigned char* ws = kargs()->ws; phase_norm(KP, l, 1, 0, NROW, (bf16_t*)(ws + OFF_B + B_HH), false, last); } grid.sync(); TS(10);
        {   unsigned char* ws = kargs()->ws;
            Gemm g; g.A = (const bf16_t*)(ws + OFF_B + B_HH); g.Bt = (const bf16_t*)(ws + OFF_W13); g.lda = 1024; g.ldb = 1024; g.K = 1024; g.perm = true;
            SchedStd S; S.init(last ? 128 : 136, 22, last ? 1 : 0);
            EpiSwi E; E.U = (bf16_t*)(ws + OFF_U);
            gemm_phase(lds, g, S, E); }
        grid.sync(); TS(11);
        {   CP* kp = kargs(); unsigned char* ws = kp->ws;
            Gemm g; g.A = (const bf16_t*)(ws + OFF_U); g.Bt = (const bf16_t*)(ws + OFF_W2); g.lda = FF; g.ldb = FF; g.K = FF; g.perm = false;
            SchedStd S; S.init(last ? 128 : 136, 4, last ? 1 : 0);
            EpiRes E; E.gmod = (const float*)(ws + OFF_MOD) + (size_t)l * 9 * 6144 + 5 * 1024; E.xo = kp->out; E.co = (float*)(ws + OFF_XSC); E.xin = (const float*)E.xo; E.cin = (const float*)E.co; E.readInput = 0;
            gemm_phase(lds, g, S, E); }
        grid.sync(); TS(12);
    }
    if (PROBE_ID >= 0 && blockIdx.x == (PROBE_ID >= 30 ? 128 : 0) && threadIdx.x == 0) { const float us = (float)(tB - tA) * 0.01f; int q = (int)(__logf(fmaxf(us, 1.0f) / 10.0f) * (1.0f / 0.0953102f) + 0.5f); q = q < 0 ? 0 : (q > 89 ? 89 : q); kargs()->out[0] = 100.0f + 10.0f * (float)q; }
}

extern "C" void kernel_launch(void* const* d_in, const int* in_sizes, int n_in, void* d_out, int out_size, void* d_ws, size_t ws_size, hipStream_t stream) {
    if (n_in < 37 || ws_size < WS_TOTAL) { fprintf(stderr, "kernel_launch: bad inputs (n_in %d, ws %zu < %zu)\n", n_in, ws_size, (size_t)WS_TOTAL); return; }
    P p{};
    const float** pp = (const float**)&p;
    for (int i = 0; i < 37; ++i) pp[i] = (const float*)d_in[i];
    p.out = (float*)d_out; p.ws = (unsigned char*)d_ws;
    static int grid_blocks = 0;
    if (!grid_blocks) {
        int dev = 0, cus = 0, per_cu = 0;
        hipGetDevice(&dev); hipDeviceGetAttribute(&cus, hipDeviceAttributeMultiprocessorCount, dev);
        hipOccupancyMaxActiveBlocksPerMultiprocessor(&per_cu, mega, 512, 0);
        if (per_cu < 1) per_cu = 1;
        grid_blocks = cus;
        if (grid_blocks > 256) grid_blocks = 256;
    }
    void* args[] = {&p};
    hipError_t e = hipLaunchCooperativeKernel((void*)mega, dim3(grid_blocks), dim3(512), args, 0, stream);
    if (e != hipSuccess) fprintf(stderr, "cooperative launch failed: %s (grid %d)\n", hipGetErrorString(e), grid_blocks);
}
```

```cpp
#include <hip/hip_runtime.h>
#include <hip/hip_cooperative_groups.h>
#include <cstdio>
namespace cg = cooperative_groups;

#define LAS __attribute__((address_space(3)))
typedef unsigned short bf16_t;
typedef short bf16x8 __attribute__((ext_vector_type(8)));
typedef short bf16x4 __attribute__((ext_vector_type(4)));
typedef float f32x4 __attribute__((ext_vector_type(4)));
typedef float f32x2 __attribute__((ext_vector_type(2)));
typedef unsigned u32x2 __attribute__((ext_vector_type(2)));

constexpr int NROW = 34816, HROWS = 17408, DM = 1024, LDB = 2688;
constexpr int C_RKV = 640, C_SGU = 2176;
constexpr int FF = 2816;

constexpr size_t OFF_WIN1 = 0, OFF_WGATE = 7864320, OFF_WO3 = 14155776, OFF_WOUT = 17301504, OFF_W13 = 19398656, OFF_W2 = 30932992,
                 OFF_WGL = 36700160, OFF_WWA = 37486592, OFF_WSGU = 37748736, OFF_MOD = 37879808, OFF_ROPE = 38322176, OFF_XSC = 39370752,
                 OFF_V0 = 47759360, OFF_RINV = 83410944, OFF_BIG = 84525056, OFF_AL = 271695872, OFF_VNT = OFF_AL + 17825792,
                 OFF_VT = OFF_VNT + 35651584, OFF_B = 342999040, WS_TOTAL = 504545280;
constexpr size_t OFF_M = OFF_AL, OFF_U = OFF_BIG;
constexpr size_t B_HH = 0, B_QKV = 35651584, B_RW = 62390272, B_SG = 124780544, B_HD = 160432128;
constexpr size_t B_G = 0, B_ASUM = 35651584, B_Y = 71303168;
constexpr size_t B_GATE = 35651584;

struct P {
    const float *x, *c, *ctx, *c_ctx, *w_mod, *b_mod, *norm_mix, *norm_ffn, *w_in, *q_gain, *k_gain, *attn_sink, *rwkv_conv, *rwkv_w0, *rwkv_w_up,
        *rwkv_a0, *rwkv_a_up, *rwkv_k_k, *rwkv_k_a, *rwkv_r_k, *rwkv_g_up, *rwkv_ln_w, *rwkv_ln_b, *vres_down, *vres_up, *vres_b, *sgu_ln_w, *sgu_ln_b,
        *sgu_w, *sgu_b, *w_o_attn, *w_o_rwkv, *w_o_sgu, *w_out, *ffn_w1, *ffn_w3, *ffn_w2;
    float* out;
    unsigned char* ws;
};


typedef const __attribute__((address_space(4))) P CP;
#define PREF CP&
__device__ __forceinline__ int ltid() { int t = threadIdx.x; asm volatile("" : "+v"(t)); return t; }
__device__ __forceinline__ f32x4 zf4() { float z = 0.f; asm volatile("" : "+v"(z)); return (f32x4){z, z, z, z}; }
__device__ __forceinline__ int lbid() { int t = blockIdx.x; asm volatile("" : "+s"(t)); return t; }
__device__ __forceinline__ CP* kargs() { CP* k = (CP*)__builtin_amdgcn_kernarg_segment_ptr(); asm volatile("" : "+s"(k)); return k; }

__shared__ __attribute__((aligned(16))) unsigned char smem[163840];

typedef __bf16 hbf2 __attribute__((ext_vector_type(2)));
__device__ __forceinline__ unsigned cvtpk(float lo, float hi) { const f32x2 v = {lo, hi}; return __builtin_bit_cast(unsigned, __builtin_convertvector(v, hbf2)); }
__device__ __forceinline__ bf16_t f2bf(float f) { return (bf16_t)(cvtpk(f, f) & 0xffffu); }
__device__ __forceinline__ float bf2f(bf16_t b) { return __uint_as_float(((unsigned)b) << 16); }
__device__ __forceinline__ float bfs(short b) { return __uint_as_float(((unsigned)(unsigned short)b) << 16); }
__device__ __forceinline__ unsigned pk2(float lo, float hi) { return cvtpk(lo, hi); }
__device__ __forceinline__ float sigm(float x) { return __builtin_amdgcn_rcpf(1.0f + __expf(-x)); }
__device__ __forceinline__ float gelu_t(float x) { float u = 0.7978845608f * (x + 0.044715f * x * x * x); float t = 1.0f - 2.0f * __builtin_amdgcn_rcpf(1.0f + __expf(2.0f * u)); return 0.5f * x * (1.0f + t); }
#define DPP_F(x, ctrl) __int_as_float(__builtin_amdgcn_update_dpp(0, __float_as_int(x), ctrl, 0xF, 0xF, true))
__device__ __forceinline__ float wsum(float v) {
    v += DPP_F(v, 0xB1); v += DPP_F(v, 0x4E); v += DPP_F(v, 0x141); v += DPP_F(v, 0x140);
    const int vi = __float_as_int(v);
    const float r0 = __int_as_float(__builtin_amdgcn_readlane(vi, 0)), r1 = __int_as_float(__builtin_amdgcn_readlane(vi, 16)), r2 = __int_as_float(__builtin_amdgcn_readlane(vi, 32)), r3 = __int_as_float(__builtin_amdgcn_readlane(vi, 48));
    return (r0 + r1) + (r2 + r3);
}
__device__ __forceinline__ void rowinfo(int r, int& b, int& t, bool& isctx) {
    int hf = r >= HROWS ? 1 : 0, rr = r - hf * HROWS;
    if (rr < 16384) { isctx = false; b = hf * 4 + (rr >> 12); t = rr & 4095; } else { isctx = true; rr -= 16384; b = hf * 4 + (rr >> 8); t = rr & 255; }
}
__device__ __forceinline__ int seg_lat(int b) { return (b >> 2) * HROWS + (b & 3) * 4096; }
__device__ __forceinline__ int seg_ctx(int b) { return (b >> 2) * HROWS + 16384 + (b & 3) * 256; }
__device__ __forceinline__ float dppf(float x, int) = delete;
__device__ __forceinline__ float red16(float v) { v += DPP_F(v, 0xB1); v += DPP_F(v, 0x4E); v += DPP_F(v, 0x141); v += DPP_F(v, 0x140); return v; }
__device__ __forceinline__ float red8(float v) { v += DPP_F(v, 0xB1); v += DPP_F(v, 0x4E); v += DPP_F(v, 0x141); return v; }

constexpr int BM = 256, BK = 64, HALF = 128, HTB = HALF * BK * 2, NXCD = 8, WGM = 8;
__device__ __forceinline__ int lds_byte(int r, int c) { const int st = (r >> 4) * 2 + (c >> 5), rr = r & 15, cc = c & 31, ob = rr * 64 + cc * 2; return st * 1024 + (ob ^ (((ob >> 9) & 1) << 5)); }
__device__ __forceinline__ void stage_rc(int b, int& R, int& C) { const int st = b / 1024, sb = b % 1024, swz = sb ^ (((sb >> 9) & 1) << 5); R = (st >> 1) * 16 + swz / 64; C = (st & 1) * 32 + (swz % 64) / 2; }
struct Unit { int pm, pn, w; };
struct UV { const char *cA, *cB; unsigned vA0, vB0; size_t hA, hB; int nt; };
__device__ __forceinline__ int perm32(int rho) { const int n = rho >> 4, i = rho & 15; return 8 * (i >> 2) + 4 * n + (i & 3); }
__device__ __forceinline__ void uv_fill(UV& v, const char* A, int lda, int pm, const char* Bt, int ldb, int pn, int K, int tid, bool perm) {
    int R0, C0; stage_rc(tid * 16, R0, C0); const int Rb = perm ? ((R0 & ~31) + perm32(R0 & 31)) : R0;
    v.vA0 = (unsigned)(R0 * lda + C0) * 2u; v.vB0 = (unsigned)(Rb * ldb + C0) * 2u;
    v.hA = (size_t)HALF * lda * 2; v.hB = (size_t)HALF * ldb * 2; v.cA = A + (size_t)pm * 2 * v.hA; v.cB = Bt + (size_t)pn * 2 * v.hB; v.nt = K / BK;
}
struct Gemm { const bf16_t *A, *Bt; int lda, ldb, K; bool perm;
    __device__ __forceinline__ void view(const Unit& u, int tid, UV& v) const {
        uv_fill(v, (const char*)A + (u.w == 1 ? C_RKV * 2 : (u.w == 2 ? C_SGU * 2 : 0)), lda, u.pm, (const char*)Bt + (size_t)u.w * (1024 * 512 * 2), ldb, u.pn, K, tid, perm); } };
struct GemmGM {
    const bf16_t *H, *Wg, *BIGp, *Wo;
    __device__ __forceinline__ void view(const Unit& u, int tid, UV& v) const {
        const int k = u.w >> 1;
        if (u.w & 1) uv_fill(v, (const char*)BIGp + (k == 1 ? C_RKV * 2 : (k == 2 ? C_SGU * 2 : 0)), LDB, u.pm, (const char*)Wo + (size_t)k * (1024 * 512 * 2), 512, u.pn, 512, tid, true);
        else uv_fill(v, (const char*)H, 1024, u.pm, (const char*)Wg + (size_t)k * (1024 * 1024 * 2), 1024, u.pn, 1024, tid, true); } };
struct SchedStd {
    int nM, nN, nwg, G, c, skip;
    __device__ void init(int nM_, int nN_, int skip_) { nM = nM_; nN = nN_; nwg = nM * nN; G = gridDim.x; c = lbid(); skip = skip_; }
    __device__ void init_sub(int nM_, int nN_, int G_, int c_) { nM = nM_; nN = nN_; nwg = nM * nN; G = G_; c = c_; skip = 0; }
    __device__ bool next(int i, Unit& u) const {
        const long L = (long)i * G + c; if (L >= nwg) return false;
        int wgid = (int)L; { const int q = nwg / NXCD, r = nwg % NXCD, xcd = wgid % NXCD, off = wgid / NXCD; wgid = (xcd < r ? xcd * (q + 1) : r * (q + 1) + (xcd - r) * q) + off; }
        const int nig = WGM * nN, gid = wgid / nig, fm = gid * WGM, gsz = (nM - fm) < WGM ? (nM - fm) : WGM;
        u.pm = fm + ((wgid % nig) % gsz); u.pn = (wgid % nig) / gsz; u.w = 0;
        if (skip && u.pm >= 64) u.pm += 4;
        return true;
    }
};
struct SchedMerge {
    int ntile, G, c;
    __device__ void init(int ntile_) { ntile = ntile_; G = gridDim.x; c = lbid(); }
    __device__ bool next(int i, Unit& u) const { const int ti = (i / 3) * G + c; if (ti >= ntile) return false; u.pm = ti >> 2; u.pn = ti & 3; u.w = i % 3; return true; }
};

struct SchedGM {
    int ntile, G, c, skip;
    __device__ void init(int ntile_, int skip_) { ntile = ntile_; G = gridDim.x; c = lbid(); skip = skip_; }
    __device__ bool next(int i, Unit& u) const { const int ti = (i / 6) * G + c; if (ti >= ntile) return false; u.pm = ti >> 2; u.pn = ti & 3; u.w = i % 6; if (skip && u.pm >= 64) u.pm += 4; return true; }
};
template <class GM, class Epi, class Sched>
__device__ __forceinline__ void gemm_phase(LAS unsigned char* lds, const GM& g, const Sched& S, const Epi& E) {
    const int tid = ltid(), wid = __builtin_amdgcn_readfirstlane(tid >> 6), lane = tid & 63, wr = wid >> 2, wc = wid & 3, fr = lane & 15, fq = lane >> 4;
    const size_t kstep = (size_t)(BK * 2);
    const unsigned ldsw = (unsigned)wid * 1024u;
    const int aoff = lds_byte(wr * 64 + fr, fq * 8), boff = lds_byte(wc * 32 + fr, fq * 8);
#define PG8_SA(b, h) (((b) * 2 + (h)) * HTB)
#define PG8_SB(b, h) ((4 + (b) * 2 + (h)) * HTB)
#define PG8_STAGE(bufoff, gbase, V0, HS) do { \
        __builtin_amdgcn_global_load_lds((const unsigned*)((const char*)(gbase) + (V0)), (LAS unsigned*)(lds + (bufoff) + ldsw), 16, 0, 0); \
        __builtin_amdgcn_global_load_lds((const unsigned*)((const char*)(gbase) + ((HS) >> 1) + (V0)), (LAS unsigned*)(lds + (bufoff) + ldsw + 8192), 16, 0, 0); } while (0)
#define PG8_LDA(dst, b, h) do { _Pragma("unroll") for (int m = 0; m < 4; ++m) _Pragma("unroll") for (int k = 0; k < 2; ++k) dst[m][k] = *(const LAS bf16x8*)(lds + PG8_SA(b, h) + aoff + m * 2048 + k * 1024); } while (0)
#define PG8_LDB(dst, b, h) do { _Pragma("unroll") for (int n = 0; n < 2; ++n) _Pragma("unroll") for (int k = 0; k < 2; ++k) dst[n][k] = *(const LAS bf16x8*)(lds + PG8_SB(b, h) + boff + n * 2048 + k * 1024); } while (0)
#define PG8_MMA(ai, bj, At, Bt) do { __builtin_amdgcn_s_setprio(1); _Pragma("unroll") for (int m = 0; m < 4; ++m) _Pragma("unroll") for (int n = 0; n < 2; ++n) _Pragma("unroll") for (int k = 0; k < 2; ++k) \
        acc[ai][bj][m][n] = __builtin_amdgcn_mfma_f32_16x16x32_bf16(Bt[n][k], At[m][k], acc[ai][bj][m][n], 0, 0, 0); __builtin_amdgcn_s_setprio(0); } while (0)
#define PG8_WAIT_V(n) asm volatile("s_waitcnt vmcnt(" #n ")" ::: "memory")
#define PG8_WAIT_L(n) asm volatile("s_waitcnt lgkmcnt(" #n ")" ::: "memory")
#define PG8_BAR __builtin_amdgcn_s_barrier()
#define PG8_SCHED __builtin_amdgcn_sched_barrier(0)
    Unit cur, nxt; int ui = 0;
    if (!S.next(0, cur)) return;
    f32x4 acc[2][2][4][2]; f32x4 zacc = zf4();
#pragma unroll
    for (int a = 0; a < 2; ++a)
#pragma unroll
        for (int b = 0; b < 2; ++b)
#pragma unroll
            for (int m = 0; m < 4; ++m)
#pragma unroll
                for (int n = 0; n < 2; ++n) acc[a][b][m][n] = zacc;
    bf16x8 At[4][2], B0[2][2], B1[2][2];
    UV C, N; g.view(cur, tid, C);
    PG8_STAGE(PG8_SB(0, 0), C.cB, C.vB0, C.hB); PG8_STAGE(PG8_SA(0, 0), C.cA, C.vA0, C.hA); PG8_STAGE(PG8_SB(0, 1), C.cB + C.hB, C.vB0, C.hB); PG8_STAGE(PG8_SA(0, 1), C.cA + C.hA, C.vA0, C.hA);
    if (wr == 1) PG8_BAR;
    PG8_WAIT_V(4); PG8_BAR;
    PG8_STAGE(PG8_SB(1, 0), C.cB + kstep, C.vB0, C.hB); PG8_STAGE(PG8_SA(1, 0), C.cA + kstep, C.vA0, C.hA); PG8_STAGE(PG8_SB(1, 1), C.cB + C.hB + kstep, C.vB0, C.hB);
    PG8_WAIT_V(6); PG8_BAR;
    for (;;) {
        const bool has_next = S.next(ui + 1, nxt);
        if (has_next) g.view(nxt, tid, N); else N = C;
        const int nt = C.nt;
        for (int t = 0; t < nt; t += 2) {
            const bool last = (t == nt - 2);
            const char* a1 = C.cA + (size_t)(t + 1) * kstep;
            const char* a2 = last ? N.cA : C.cA + (size_t)(t + 2) * kstep; const char* b2 = last ? N.cB : C.cB + (size_t)(t + 2) * kstep;
            const char* a3 = a2 + kstep; const char* b3 = b2 + kstep;
            const unsigned xa0 = last ? N.vA0 : C.vA0, xb0 = last ? N.vB0 : C.vB0;
            const size_t xhA = last ? N.hA : C.hA, xhB = last ? N.hB : C.hB;
            PG8_LDB(B0, 0, 0); PG8_SCHED; PG8_LDA(At, 0, 0); PG8_STAGE(PG8_SA(1, 1), a1 + C.hA, C.vA0, C.hA);
            PG8_WAIT_L(8); PG8_BAR; PG8_WAIT_L(0); PG8_MMA(0, 0, At, B0); PG8_BAR; PG8_SCHED;
            PG8_LDB(B1, 0, 1); PG8_STAGE(PG8_SB(0, 0), b2, xb0, xhB);
            PG8_BAR; PG8_WAIT_L(0); PG8_MMA(0, 1, At, B1); PG8_BAR;
            PG8_LDA(At, 0, 1); PG8_STAGE(PG8_SA(0, 0), a2, xa0, xhA);
            PG8_BAR; PG8_WAIT_L(0); PG8_MMA(1, 0, At, B0); PG8_BAR; PG8_SCHED;
            PG8_STAGE(PG8_SB(0, 1), b2 + xhB, xb0, xhB);
            PG8_WAIT_V(6); PG8_BAR; PG8_MMA(1, 1, At, B1); PG8_BAR;
            PG8_LDB(B0, 1, 0); PG8_SCHED; PG8_LDA(At, 1, 0); PG8_STAGE(PG8_SA(0, 1), a2 + xhA, xa0, xhA);
            PG8_WAIT_L(8); PG8_BAR; PG8_WAIT_L(0); PG8_MMA(0, 0, At, B0); PG8_BAR; PG8_SCHED;
            PG8_LDB(B1, 1, 1); PG8_STAGE(PG8_SB(1, 0), b3, xb0, xhB);
            PG8_BAR; PG8_WAIT_L(0); PG8_MMA(0, 1, At, B1); PG8_BAR;
            PG8_LDA(At, 1, 1); PG8_STAGE(PG8_SA(1, 0), a3, xa0, xhA);
            PG8_BAR; PG8_WAIT_L(0); PG8_MMA(1, 0, At, B0); PG8_BAR; PG8_SCHED;
            PG8_STAGE(PG8_SB(1, 1), b3 + xhB, xb0, xhB);
            PG8_WAIT_V(6); PG8_BAR; PG8_MMA(1, 1, At, B1); PG8_BAR;
        }
        E(acc, cur, wr, wc, fr, fq);
        if (!has_next) break;
        zacc = zf4();
#pragma unroll
        for (int a = 0; a < 2; ++a)
#pragma unroll
            for (int b = 0; b < 2; ++b)
#pragma unroll
                for (int m = 0; m < 4; ++m)
#pragma unroll
                    for (int n = 0; n < 2; ++n) acc[a][b][m][n] = zacc;
        cur = nxt; C = N; ++ui;
    }
    PG8_WAIT_V(0);
    if (wr == 0) PG8_BAR;
    PG8_BAR;
}

#define EPI_LOOP_ROWS for (int ai = 0; ai < 2; ++ai) for (int m = 0; m < 4; ++m, __builtin_amdgcn_sched_barrier(0))
#define EPI_LOOP_COLS for (int bj = 0; bj < 2; ++bj) for (int n = 0; n < 2; ++n)
#define EPI_LOOP_COLS_SB for (int bj = 0; bj < 2; ++bj) for (int n = 0; n < 2; ++n, __builtin_amdgcn_sched_barrier(0))
__device__ __forceinline__ void st_bf4(bf16_t* p, f32x4 v) { uint2 o; o.x = pk2(v[0], v[1]); o.y = pk2(v[2], v[3]); *(uint2*)p = o; }

__device__ __forceinline__ void st_bf8(bf16_t* p, f32x4 a, f32x4 b) { uint4 o; o.x = pk2(a[0], a[1]); o.y = pk2(a[2], a[3]); o.z = pk2(b[0], b[1]); o.w = pk2(b[2], b[3]); *(uint4*)p = o; }
struct EpiIn {
    bf16_t *qkv, *rw, *sg, *hd;
    __device__ __forceinline__ void operator()(const f32x4 (&acc)[2][2][4][2], const Unit& u, int wr, int wc, int fr, int fq) const {
        asm volatile("" : "+v"(fr), "+v"(fq));
        bf16_t* base; int ld, c0;
        if (u.pn < 3) { base = qkv; ld = 768; c0 = u.pn * 256; } else if (u.pn < 10) { base = rw; ld = 1792; c0 = (u.pn - 3) * 256; }
        else if (u.pn < 14) { base = sg; ld = 1024; c0 = (u.pn - 10) * 256; } else { base = hd; ld = 32; c0 = 0; }
        const bool hdt = u.pn >= 14;
#pragma unroll
        EPI_LOOP_ROWS { const int row = u.pm * 256 + ai * 128 + wr * 64 + m * 16 + fr;
#pragma unroll
            for (int bj = 0; bj < 2; ++bj) { const int col = bj * 128 + wc * 32 + fq * 8; if (hdt && (bj != 0 || wc != 0)) continue; st_bf8(base + (size_t)row * ld + c0 + col, acc[ai][bj][m][0], acc[ai][bj][m][1]); } }
    }
};
struct EpiPlain {
    bf16_t* o; int ld; int act;
    __device__ __forceinline__ void operator()(const f32x4 (&acc)[2][2][4][2], const Unit& u, int wr, int wc, int fr, int fq) const {
        asm volatile("" : "+v"(fr), "+v"(fq));
#pragma unroll
        EPI_LOOP_ROWS { const int row = u.pm * 256 + ai * 128 + wr * 64 + m * 16 + fr;
#pragma unroll
            for (int bj = 0; bj < 2; ++bj) { const int col = u.pn * 256 + bj * 128 + wc * 32 + fq * 8; f32x4 v = acc[ai][bj][m][0], w = acc[ai][bj][m][1];
                if (act) { v[0] = sigm(v[0]); v[1] = sigm(v[1]); v[2] = sigm(v[2]); v[3] = sigm(v[3]); w[0] = sigm(w[0]); w[1] = sigm(w[1]); w[2] = sigm(w[2]); w[3] = sigm(w[3]); }
                st_bf8(o + (size_t)row * ld + col, v, w); } }
    }
};
struct EpiAsum {
    bf16_t* asum; const float* a0;
    __device__ __forceinline__ void operator()(const f32x4 (&acc)[2][2][4][2], const Unit& u, int wr, int wc, int fr, int fq) const {
        asm volatile("" : "+v"(fr), "+v"(fq));
        const int col0 = u.pn * 128 + wc * 32 + fq * 8;
        f32x4 b0[2], b1[2];
#pragma unroll
        for (int n = 0; n < 2; ++n) { b0[n] = *(const f32x4*)(a0 + col0 + n * 4); b1[n] = *(const f32x4*)(a0 + 512 + col0 + n * 4); }
#pragma unroll
        EPI_LOOP_ROWS { const int row = u.pm * 256 + ai * 128 + wr * 64 + m * 16 + fr; f32x4 v[2];
#pragma unroll
            for (int n = 0; n < 2; ++n)
#pragma unroll
                for (int e = 0; e < 4; ++e) v[n][e] = sigm(b0[n][e] + acc[ai][0][m][n][e]) + sigm(b1[n][e] + acc[ai][1][m][n][e]);
            st_bf8(asum + (size_t)row * 512 + col0, v[0], v[1]); }
    }
};
struct EpiMerge {
    const bf16_t* gate; bf16_t* M; int row0;
    __device__ __forceinline__ void operator()(const f32x4 (&acc)[2][2][4][2], const Unit& u, int wr, int wc, int fr, int fq) const {
        asm volatile("" : "+v"(fr), "+v"(fq));
#pragma unroll
        EPI_LOOP_ROWS { const int row = u.pm * 256 + ai * 128 + wr * 64 + m * 16 + fr;
#pragma unroll
            EPI_LOOP_COLS { const int col = u.pn * 256 + bj * 128 + wc * 32 + n * 16 + fq * 4;
                const bf16x4 gt = *(const bf16x4*)(gate + (size_t)row * 3072 + u.w * 1024 + col);
                bf16_t* mp = M + (size_t)(row0 + row) * 1024 + col; f32x4 v;
#pragma unroll
                for (int e = 0; e < 4; ++e) v[e] = bfs(gt[e]) * acc[ai][bj][m][n][e];
                if (u.w != 0) { const bf16x4 old = *(const bf16x4*)mp;
#pragma unroll
                    for (int e = 0; e < 4; ++e) v[e] += bfs(old[e]); }
                st_bf4(mp, v); } }
    }
};
struct EpiGM {
    bf16_t* scr; bf16_t* M;
    __device__ __forceinline__ void operator()(const f32x4 (&acc)[2][2][4][2], const Unit& u, int wr, int wc, int fr, int fq) const {
        asm volatile("" : "+v"(fr), "+v"(fq));
        bf16_t* scr = this->scr; asm volatile("" : "+s"(scr));
        if (!(u.w & 1)) {
#pragma unroll
            EPI_LOOP_ROWS { const int rl = ai * 128 + wr * 64 + m * 16 + fr;
#pragma unroll
                EPI_LOOP_COLS_SB { const int cl = bj * 128 + wc * 32 + fq * 8 + n * 4; f32x4 v = acc[ai][bj][m][n];
                    v[0] = sigm(v[0]); v[1] = sigm(v[1]); v[2] = sigm(v[2]); v[3] = sigm(v[3]); st_bf4(scr + rl * 256 + cl, v); } }
        } else {
#pragma unroll
            for (int ai = 0; ai < 2; ++ai) {
                u32x2 gr[4][2][2]; bf16x4 od[4][2][2];
#pragma unroll
                for (int m = 0; m < 4; ++m) { const int rl = ai * 128 + wr * 64 + m * 16 + fr, row = u.pm * 256 + rl;
#pragma unroll
                    for (int bj = 0; bj < 2; ++bj)
#pragma unroll
                        for (int n = 0; n < 2; ++n) { const int cl = bj * 128 + wc * 32 + fq * 8 + n * 4, col = u.pn * 256 + cl;
                            { const unsigned long long gq = __hip_atomic_load((const __attribute__((address_space(1))) unsigned long long*)(scr + rl * 256 + cl), __ATOMIC_RELAXED, __HIP_MEMORY_SCOPE_AGENT);
                              gr[m][bj][n] = __builtin_bit_cast(u32x2, gq); }
                            od[m][bj][n] = (u.w != 1) ? *(const bf16x4*)(M + (size_t)row * 1024 + col) : (bf16x4){0, 0, 0, 0}; } }
#pragma unroll
                for (int m = 0; m < 4; ++m) { const int rl = ai * 128 + wr * 64 + m * 16 + fr, row = u.pm * 256 + rl;
#pragma unroll
                    for (int bj = 0; bj < 2; ++bj)
#pragma unroll
                        for (int n = 0; n < 2; ++n) { const int cl = bj * 128 + wc * 32 + fq * 8 + n * 4, col = u.pn * 256 + cl; const u32x2 graw = gr[m][bj][n]; f32x4 v;
                            v[0] = __uint_as_float(graw.x << 16) * acc[ai][bj][m][n][0] + bfs(od[m][bj][n][0]); v[1] = __uint_as_float(graw.x & 0xffff0000u) * acc[ai][bj][m][n][1] + bfs(od[m][bj][n][1]);
                            v[2] = __uint_as_float(graw.y << 16) * acc[ai][bj][m][n][2] + bfs(od[m][bj][n][2]); v[3] = __uint_as_float(graw.y & 0xffff0000u) * acc[ai][bj][m][n][3] + bfs(od[m][bj][n][3]);
                            st_bf4(M + (size_t)row * 1024 + col, v); } }
                __builtin_amdgcn_sched_barrier(0);
            }
        }
    }
};
struct EpiRes {
    const float* gmod;
    const float *xin, *cin; float *xo, *co; int readInput;
    __device__ __forceinline__ void operator()(const f32x4 (&acc)[2][2][4][2], const Unit& u, int wr, int wc, int fr, int fq) const {
        asm volatile("" : "+v"(fr), "+v"(fq));
        int b0, t0; bool ic0; rowinfo(u.pm * 256, b0, t0, ic0); const bool ic = __builtin_amdgcn_readfirstlane((int)ic0) != 0;
        const float* sx = xin; const float* sc_ = cin; asm volatile("" : "+s"(sx), "+s"(sc_));
        const float* srcb = (ic ? sc_ : sx) + (ic ? ((size_t)(b0 * 256 + t0) * 1024) : ((size_t)(b0 * 4096 + t0) * 1024));
        float* dstb = (ic ? co : xo) + (ic ? ((size_t)(b0 * 256 + t0) * 1024) : ((size_t)(b0 * 4096 + t0) * 1024));
        const float* gm = gmod + (ic ? 8 : b0) * 6144 + u.pn * 256 + wc * 32 + fq * 4;
        f32x4 gg[2][2];
#pragma unroll
        for (int bj = 0; bj < 2; ++bj)
#pragma unroll
            for (int n = 0; n < 2; ++n) gg[bj][n] = *(const f32x4*)(gm + bj * 128 + n * 16);
#pragma unroll
        for (int ai = 0; ai < 2; ++ai) {
            f32x4 r[4][2][2];
#pragma unroll
            for (int m = 0; m < 4; ++m) { const size_t ro = (size_t)(ai * 128 + wr * 64 + m * 16 + fr) * 1024 + u.pn * 256 + wc * 32 + fq * 4;
#pragma unroll
                for (int bj = 0; bj < 2; ++bj)
#pragma unroll
                    for (int n = 0; n < 2; ++n) r[m][bj][n] = *(const f32x4*)(srcb + ro + bj * 128 + n * 16); }
#pragma unroll
            for (int m = 0; m < 4; ++m) { const size_t ro = (size_t)(ai * 128 + wr * 64 + m * 16 + fr) * 1024 + u.pn * 256 + wc * 32 + fq * 4;
#pragma unroll
                for (int bj = 0; bj < 2; ++bj)
#pragma unroll
                    for (int n = 0; n < 2; ++n) *(f32x4*)(dstb + ro + bj * 128 + n * 16) = r[m][bj][n] + gg[bj][n] * acc[ai][bj][m][n]; }
            __builtin_amdgcn_sched_barrier(0);
        }
    }
};
struct EpiSwi {
    bf16_t* U;
    __device__ __forceinline__ void operator()(const f32x4 (&acc)[2][2][4][2], const Unit& u, int wr, int wc, int fr, int fq) const {
        asm volatile("" : "+v"(fr), "+v"(fq));
#pragma unroll
        EPI_LOOP_ROWS { const int row = u.pm * 256 + ai * 128 + wr * 64 + m * 16 + fr;
#pragma unroll
            for (int once = 0; once < 1; ++once) { const int col = u.pn * 128 + wc * 32 + fq * 8; f32x4 v[2];
#pragma unroll
              for (int n = 0; n < 2; ++n)
#pragma unroll
                for (int e = 0; e < 4; ++e) { const float a = acc[ai][0][m][n][e]; v[n][e] = a * sigm(a) * acc[ai][1][m][n][e]; }
              st_bf8(U + (size_t)row * FF + col, v[0], v[1]); } }
    }
};

__device__ __forceinline__ void tconv(const float* src, int lds_, int K, int N, bf16_t* dst, int ldd, int mode, int& jobbase) {
    float* tile = (float*)smem;
    const int nkt = K >> 6, nnt = (N + 63) >> 6, njobs = nkt * nnt, G = gridDim.x;
    const int first = (((int)lbid() - jobbase % G) + G) % G;
    const int tid = ltid();
    for (int j0 = first; j0 < njobs; j0 += 2 * G) {
        float v[2][8]; int k0s[2], n0s[2]; bool ok[2];
#pragma unroll
        for (int u = 0; u < 2; ++u) { const int j = j0 + u * G; ok[u] = j < njobs; const int jj = ok[u] ? j : j0; const int kt = jj % nkt, ntile = jj / nkt; k0s[u] = kt << 6; n0s[u] = ntile << 6;
#pragma unroll
            for (int e = 0; e < 8; ++e) { const int k = e * 8 + (tid >> 6), n = tid & 63; v[u][e] = (ok[u] && n0s[u] + n < N) ? src[(size_t)(k0s[u] + k) * lds_ + n0s[u] + n] : 0.f; } }
        __syncthreads();
#pragma unroll
        for (int u = 0; u < 2; ++u)
#pragma unroll
            for (int e = 0; e < 8; ++e) tile[u * 4160 + (e * 8 + (tid >> 6)) * 65 + (tid & 63)] = v[u][e];
        __syncthreads();
#pragma unroll
        for (int u = 0; u < 2; ++u) { const int n = tid >> 3, kq = tid & 7, ng = n0s[u] + n; const float* tl = tile + u * 4160;
            if (ok[u] && ng < N) { const int row = mode == 0 ? ng : ((ng >> 7) * 256 + (ng & 127) + (mode == 2 ? 128 : 0)); uint4 st;
                st.x = pk2(tl[(kq * 8 + 0) * 65 + n], tl[(kq * 8 + 1) * 65 + n]); st.y = pk2(tl[(kq * 8 + 2) * 65 + n], tl[(kq * 8 + 3) * 65 + n]);
                st.z = pk2(tl[(kq * 8 + 4) * 65 + n], tl[(kq * 8 + 5) * 65 + n]); st.w = pk2(tl[(kq * 8 + 6) * 65 + n], tl[(kq * 8 + 7) * 65 + n]);
                *(uint4*)(dst + (size_t)row * ldd + k0s[u] + kq * 8) = st; } }
    }
    jobbase += njobs;
    __syncthreads();
}
__device__ __forceinline__ void zfill(void* ptr, size_t bytes) {
    uint4* q = (uint4*)ptr; const size_t n = bytes >> 4; unsigned z0 = 0; asm volatile("" : "+v"(z0)); const uint4 z = {z0, z0, z0, z0};
    for (size_t i = (size_t)lbid() * 512 + ltid(); i < n; i += (size_t)gridDim.x * 512) q[i] = z;
}
__device__ __forceinline__ void phase_W(PREF p, int l) {
    unsigned char* ws = p.ws; int jb = 0;
    bf16_t* win1 = (bf16_t*)(ws + OFF_WIN1);
    if (l == 1) zfill(win1 + (size_t)(3584 + 32) * 1024, (size_t)224 * 1024 * 2);
    {
        bf16_t* wgl = (bf16_t*)(ws + OFF_WGL);
        for (int i = lbid() * 512 + ltid(); i < 1536 * 256; i += gridDim.x * 512) { const int r = i >> 8, k = i & 255; const bool wr_ = r < 512 ? (k >= 128) : (k >= 64 && k < 128); if (!wr_) wgl[i] = 0; }
    }
    tconv(p.w_in + (size_t)l * 1024 * 6656, 6656, 1024, 3584, win1, 1024, 0, jb);
    if (l == 1) tconv(p.vres_down, 32, 1024, 32, win1 + (size_t)3584 * 1024, 1024, 0, jb);
    tconv(p.w_in + (size_t)l * 1024 * 6656 + 3584, 6656, 1024, 3072, (bf16_t*)(ws + OFF_WGATE), 1024, 0, jb);
    tconv(p.w_o_attn + (size_t)l * 512 * 1024, 1024, 512, 1024, (bf16_t*)(ws + OFF_WO3), 512, 0, jb);
    tconv(p.w_o_rwkv + (size_t)l * 512 * 1024, 1024, 512, 1024, (bf16_t*)(ws + OFF_WO3) + 1024 * 512, 512, 0, jb);
    tconv(p.w_o_sgu + (size_t)l * 512 * 1024, 1024, 512, 1024, (bf16_t*)(ws + OFF_WO3) + 2 * 1024 * 512, 512, 0, jb);
    tconv(p.w_out + (size_t)l * 1024 * 1024, 1024, 1024, 1024, (bf16_t*)(ws + OFF_WOUT), 1024, 0, jb);
    tconv(p.ffn_w1 + (size_t)l * 1024 * FF, FF, 1024, FF, (bf16_t*)(ws + OFF_W13), 1024, 1, jb);
    tconv(p.ffn_w3 + (size_t)l * 1024 * FF, FF, 1024, FF, (bf16_t*)(ws + OFF_W13), 1024, 2, jb);
    tconv(p.ffn_w2 + (size_t)l * FF * 1024, 1024, FF, 1024, (bf16_t*)(ws + OFF_W2), FF, 0, jb);
    tconv(p.rwkv_g_up + (size_t)l * 128 * 512, 512, 128, 512, (bf16_t*)(ws + OFF_WGL) + 128, 256, 0, jb);
    tconv(p.rwkv_a_up + (size_t)(l * 2 + 0) * 64 * 512, 512, 64, 512, (bf16_t*)(ws + OFF_WGL) + 512 * 256 + 64, 256, 1, jb);
    tconv(p.rwkv_a_up + (size_t)(l * 2 + 1) * 64 * 512, 512, 64, 512, (bf16_t*)(ws + OFF_WGL) + 512 * 256 + 64, 256, 2, jb);
    for (int d = 0; d < 2; ++d) {
        tconv(p.rwkv_w_up + (size_t)(l * 2 + d) * 64 * 512, 512, 64, 512, (bf16_t*)(ws + OFF_WWA) + (size_t)(d * 2 + 0) * 512 * 64, 64, 0, jb);
        tconv(p.rwkv_a_up + (size_t)(l * 2 + d) * 64 * 512, 512, 64, 512, (bf16_t*)(ws + OFF_WWA) + (size_t)(d * 2 + 1) * 512 * 64, 64, 0, jb);
    }
    {   bf16_t* wsg = (bf16_t*)(ws + OFF_WSGU); const float* s = p.sgu_w + (size_t)l * 65536;
        for (int i = lbid() * 512 + ltid(); i < 65536; i += gridDim.x * 512) wsg[i] = f2bf(s[i]); }
    if (l == 0) {
        float* cs = (float*)(ws + OFF_ROPE);
        for (int i = lbid() * 512 + ltid(); i < 4096 * 32; i += gridDim.x * 512) { const int t = i >> 5, f = i & 31; const float pos = (float)(f < 16 ? (t >> 6) : (t & 63));
            const float inv = exp2f(-(float)(f & 15) * (13.287712379549449f / 16.0f)); const float ang = pos * inv; cs[2 * i] = __cosf(ang); cs[2 * i + 1] = __sinf(ang); }
        float* sc = (float*)smem; float* red = sc + 9 * 1024; float* mod = (float*)(ws + OFF_MOD);
        __syncthreads();
        for (int i = ltid(); i < 9 * 1024; i += 512) { const float v = i < 8192 ? p.c[i] : p.c_ctx[i - 8192]; sc[i] = v * sigm(v); }
        __syncthreads();
        for (int it = lbid(); it < 192; it += gridDim.x) {
            const int ll = it / 96, j0 = (it % 96) * 64, kg = ltid() >> 6, jj = ltid() & 63;
            float a[9];
#pragma unroll
            for (int r = 0; r < 9; ++r) a[r] = 0.f;
            const float* wp = p.w_mod + (size_t)ll * 1024 * 6144 + j0 + jj;
            for (int i0 = kg * 128; i0 < kg * 128 + 128; i0 += 16) { float wv[16];
#pragma unroll
                for (int u = 0; u < 16; ++u) wv[u] = wp[(size_t)(i0 + u) * 6144];
#pragma unroll
                for (int u = 0; u < 16; ++u)
#pragma unroll
                    for (int r = 0; r < 9; ++r) a[r] += sc[r * 1024 + i0 + u] * wv[u]; }
            __syncthreads();
#pragma unroll
            for (int r = 0; r < 9; ++r) red[(kg * 9 + r) * 64 + jj] = a[r];
            __syncthreads();
            for (int idx = ltid(); idx < 576; idx += 512) { const int r = idx >> 6, j2 = idx & 63; float s = 0.f; for (int k2 = 0; k2 < 8; ++k2) s += red[(k2 * 9 + r) * 64 + j2];
                mod[(size_t)(ll * 9 + r) * 6144 + j0 + j2] = s + p.b_mod[(size_t)ll * 6144 + j0 + j2]; }
        }
        __syncthreads();
    }
}

__device__ __forceinline__ void phase_norm(PREF p, int l, int which, int r0, int nrows, bf16_t* dst, bool readInput, bool skipctx) {
    const int lane = ltid() & 63, gw = lbid() * 8 + (ltid() >> 6), nw = gridDim.x * 8;
    const float* mod = (const float*)(p.ws + OFF_MOD) + (size_t)l * 9 * 6144; const float* xsc = (const float*)(p.ws + OFF_XSC);
    const float* gain = (which ? p.norm_ffn : p.norm_mix) + l * 1024;
    f32x4 gn[4];
#pragma unroll
    for (int e = 0; e < 4; ++e) gn[e] = *(const f32x4*)(gain + e * 256 + lane * 4);
    for (int ri0 = gw; ri0 < nrows; ri0 += 4 * nw) {
        f32x4 v[4][4]; const float* mr[4]; bool act[4];
#pragma unroll
        for (int k = 0; k < 4; ++k) {
            const int ri = ri0 + k * nw; act[k] = ri < nrows; const int r = r0 + (act[k] ? ri : ri0); int b, t; bool ic; rowinfo(r, b, t, ic);
            if (skipctx && ic) act[k] = false;
            const float* src = ic ? ((readInput ? p.ctx : xsc) + (size_t)(b * 256 + t) * 1024) : ((readInput ? p.x : p.out) + (size_t)(b * 4096 + t) * 1024);
            mr[k] = mod + (ic ? 8 : b) * 6144 + (which ? 3 : 0) * 1024;
#pragma unroll
            for (int e = 0; e < 4; ++e) v[k][e] = *(const f32x4*)(src + e * 256 + lane * 4);
        }
#pragma unroll
        for (int k = 0; k < 4; ++k) {
            float ss = 0.f;
#pragma unroll
            for (int e = 0; e < 4; ++e) ss += v[k][e][0] * v[k][e][0] + v[k][e][1] * v[k][e][1] + v[k][e][2] * v[k][e][2] + v[k][e][3] * v[k][e][3];
            ss = wsum(ss); const float rstd = rsqrtf(ss * (1.0f / 1024.0f) + 1e-6f);
            if (act[k]) {
                const int ri = ri0 + k * nw;
#pragma unroll
                for (int e = 0; e < 4; ++e) { const int c = e * 256 + lane * 4; const f32x4 sh = *(const f32x4*)(mr[k] + c), sc = *(const f32x4*)(mr[k] + 1024 + c);
                    f32x4 h = v[k][e] * rstd * gn[e] * (sc + 1.0f) + sh; st_bf4(dst + (size_t)ri * 1024 + c, h); }
            }
        }
    }
}

__device__ __forceinline__ void phase_prep(PREF p, int l, int hf) {
    unsigned char* ws = p.ws; const int tid = ltid(), lane = tid & 63, wave = tid >> 6;
    const bf16_t* QKVh = (const bf16_t*)(ws + OFF_B + B_QKV); const bf16_t* RWh = (const bf16_t*)(ws + OFF_B + B_RW);
    const bf16_t* SGh = (const bf16_t*)(ws + OFF_B + B_SG); const bf16_t* HDh = (const bf16_t*)(ws + OFF_B + B_HD);
    bf16_t* BIG = (bf16_t*)(ws + OFF_BIG); bf16_t* AL = (bf16_t*)(ws + OFF_AL); bf16_t* vnT = (bf16_t*)(ws + OFF_VNT);
    bf16_t* vTl = (bf16_t*)(ws + OFF_VT); bf16_t* vTc = vTl + (size_t)8 * 128 * 4096; bf16_t* V0 = (bf16_t*)(ws + OFF_V0); float* RINV = (float*)(ws + OFF_RINV);
    const float* cs = (const float*)(ws + OFF_ROPE);
    bf16_t* lt = (bf16_t*)smem;
    const int ch = tid * 4; float cw[3][4] = {{0}}, kkw[4] = {0, 0, 0, 0}, vb[4] = {0, 0, 0, 0};
    if (tid < 448) { for (int i = 0; i < 3; ++i) for (int e = 0; e < 4; ++e) cw[i][e] = p.rwkv_conv[(size_t)(l * 3 + i) * 1792 + ch + e]; }
    if (tid >= 128 && tid < 256) for (int e = 0; e < 4; ++e) kkw[e] = p.rwkv_k_k[l * 512 + ch - 512 + e];
    const bool isv = tid >= 256 && tid < 384;
    float* upl = (float*)(smem + 49152);
    if (l == 1) { for (int i = tid; i < 32 * 512; i += 512) upl[i] = p.vres_up[i]; if (isv) for (int e = 0; e < 4; ++e) vb[e] = p.vres_b[ch - 1024 + e]; }
    __syncthreads();
    for (int strip = lbid(); strip < HROWS / 16; strip += gridDim.x) {
        const int rr0 = strip * 16, r0 = hf * HROWS + rr0; int b, t0; bool ic; rowinfo(r0, b, t0, ic);
        const int T = ic ? 256 : 4096;
        {
            const int g = lane & 7;
            bf16x8 raws[2][2]; f32x4 csv[2][4];
#pragma unroll
            for (int i = 0; i < 2; ++i) {
                const int rr = rr0 + wave * 2 + i, t = t0 + wave * 2 + i;
                raws[i][0] = *(const bf16x8*)(QKVh + (size_t)rr * 768 + (lane >> 3) * 64 + g * 8);
                raws[i][1] = *(const bf16x8*)(QKVh + (size_t)rr * 768 + 512 + ((lane >> 3) & 1) * 64 + g * 8);
                const float* cp = cs + (size_t)((ic ? 0 : t) * 32 + (g & 3) * 8) * 2;
#pragma unroll
                for (int q4 = 0; q4 < 4; ++q4) csv[i][q4] = *(const f32x4*)(cp + q4 * 4);
            }
#pragma unroll
            for (int i = 0; i < 2; ++i) {
                const int rr = rr0 + wave * 2 + i, r = hf * HROWS + rr;
#pragma unroll
                for (int pass = 0; pass < 2; ++pass) {
                    const int hh = pass == 0 ? (lane >> 3) : ((lane >> 3) & 1);
                    const int scol = pass == 0 ? hh * 64 + g * 8 : 512 + hh * 64 + g * 8;
                    const bf16x8 raw = raws[i][pass];
                    const float* gn = (pass == 0 ? p.q_gain : p.k_gain) + l * 64 + g * 8;
                    float x[8], ss = 0.f;
#pragma unroll
                    for (int e = 0; e < 8; ++e) { x[e] = bfs(raw[e]); ss += x[e] * x[e]; }
                    ss += __shfl_xor(ss, 1); ss += __shfl_xor(ss, 2); ss += __shfl_xor(ss, 4);
                    const float rstd = rsqrtf(ss * (1.0f / 64.0f) + 1e-6f);
#pragma unroll
                    for (int e = 0; e < 8; ++e) x[e] = x[e] * rstd * gn[e];
                    float y[8];
#pragma unroll
                    for (int e = 0; e < 8; ++e) { const float o = __shfl_xor(x[e], 4);
                        if (ic) y[e] = x[e];
                        else { const float co = csv[i][e >> 1][(e & 1) * 2], si = csv[i][e >> 1][(e & 1) * 2 + 1];
                            y[e] = (g < 4) ? (x[e] * co - o * si) : (o * si + x[e] * co); } }
                    const float scl = pass == 0 ? 0.125f : 1.0f;
                    uint4 st; st.x = pk2(y[0] * scl, y[1] * scl); st.y = pk2(y[2] * scl, y[3] * scl); st.z = pk2(y[4] * scl, y[5] * scl); st.w = pk2(y[6] * scl, y[7] * scl);
                    if (pass == 0 || lane < 16) *(uint4*)(BIG + (size_t)r * LDB + scol) = st;
                }
            }
        }
        __syncthreads();
        if (tid < 256) { const int row = tid >> 4, cq = tid & 15; *(uint4*)(lt + row * 136 + cq * 8) = *(const uint4*)(QKVh + (size_t)(rr0 + row) * 768 + 640 + cq * 8); }
        __syncthreads();
        if (tid < 256) { const int c = tid >> 1, tq = tid & 1; bf16_t tmp[8];
#pragma unroll
            for (int e = 0; e < 8; ++e) tmp[e] = lt[(tq * 8 + e) * 136 + c];
            uint4 st; st.x = tmp[0] | ((unsigned)tmp[1] << 16); st.y = tmp[2] | ((unsigned)tmp[3] << 16); st.z = tmp[4] | ((unsigned)tmp[5] << 16); st.w = tmp[6] | ((unsigned)tmp[7] << 16);
            const int kvh_ = c >> 6, d_ = c & 63, kb_ = t0 >> 6, tt_ = (t0 & 63) + tq * 8;
            bf16_t* dstp = ic ? (vTc + ((size_t)((b * 2 + kvh_) * 4 + kb_) * 64 + d_) * 64 + tt_) : (vTl + ((size_t)((b * 2 + kvh_) * 64 + kb_) * 64 + d_) * 64 + tt_);
            *(uint4*)dstp = st; }
        __syncthreads();
        bf16x8 urs[2], vrs[2];
#pragma unroll
        for (int i = 0; i < 2; ++i) { const int rr = rr0 + wave * 2 + i; urs[i] = *(const bf16x8*)(SGh + (size_t)rr * 1024 + lane * 8); vrs[i] = *(const bf16x8*)(SGh + (size_t)rr * 1024 + 512 + lane * 8); }
#pragma unroll
        for (int i = 0; i < 2; ++i) {
            const int rl = wave * 2 + i, rr = rr0 + rl, r = hf * HROWS + rr;
            const bf16x8 ur = urs[i], vr = vrs[i];
            float u[8], v[8], s1 = 0.f;
#pragma unroll
            for (int e = 0; e < 8; ++e) { u[e] = gelu_t(bfs(ur[e])); v[e] = gelu_t(bfs(vr[e])); s1 += v[e]; }
            uint4 st; st.x = pk2(u[0], u[1]); st.y = pk2(u[2], u[3]); st.z = pk2(u[4], u[5]); st.w = pk2(u[6], u[7]);
            *(uint4*)(BIG + (size_t)r * LDB + C_SGU + lane * 8) = st;
            const float mu = wsum(s1) * (1.0f / 512.0f); float s2 = 0.f;
#pragma unroll
            for (int e = 0; e < 8; ++e) { v[e] -= mu; s2 += v[e] * v[e]; }
            const float rstd = rsqrtf(wsum(s2) * (1.0f / 512.0f) + 1e-6f);
            const float* lw = p.sgu_ln_w + l * 512 + lane * 8; const float* lb = p.sgu_ln_b + l * 512 + lane * 8;
#pragma unroll
            for (int e = 0; e < 8; ++e) lt[rl * 520 + lane * 8 + e] = f2bf(v[e] * rstd * lw[e] + lb[e]);
        }
        __syncthreads();
        { const int c = tid;
#pragma unroll
            for (int q4 = 0; q4 < 2; ++q4) { bf16_t tmp[8];
#pragma unroll
                for (int e = 0; e < 8; ++e) tmp[e] = lt[(q4 * 8 + e) * 520 + c];
                uint4 st; st.x = tmp[0] | ((unsigned)tmp[1] << 16); st.y = tmp[2] | ((unsigned)tmp[3] << 16); st.z = tmp[4] | ((unsigned)tmp[5] << 16); st.w = tmp[6] | ((unsigned)tmp[7] << 16);
                *(uint4*)(vnT + ((size_t)(r0 >> 7) * 512 + c) * 128 + (r0 & 127) + q4 * 8) = st; } }
        __syncthreads();
        if (l == 1) { bf16_t* hdl = lt + 8192; if (tid < 64) *(uint4*)(hdl + tid * 8) = *(const uint4*)(HDh + (size_t)rr0 * 32 + tid * 8); }
        __syncthreads();
        if (tid < 448) {
            float pv[4], cv[4], nv[4];
            { const bool ok = t0 > 0; const bf16x4 a = ok ? *(const bf16x4*)(RWh + (size_t)(rr0 - 1) * 1792 + ch) : (bf16x4){0, 0, 0, 0};
              const bf16x4 c2 = *(const bf16x4*)(RWh + (size_t)rr0 * 1792 + ch);
#pragma unroll
              for (int e = 0; e < 4; ++e) { pv[e] = bfs(a[e]); cv[e] = bfs(c2[e]); } }
            for (int bt = 0; bt < 1; ++bt) {
                bf16x4 nxt[16], vfs[16];
#pragma unroll
                for (int i = 0; i < 16; ++i) { const int ii = bt * 16 + i; const bool ok = t0 + ii + 1 < T;
                    nxt[i] = ok ? *(const bf16x4*)(RWh + (size_t)(rr0 + ii + 1) * 1792 + ch) : (bf16x4){0, 0, 0, 0};
                    vfs[i] = (l == 1 && isv) ? *(const bf16x4*)(V0 + (size_t)(hf * HROWS + rr0 + ii) * 512 + ch - 1024) : (bf16x4){0, 0, 0, 0}; }
#pragma unroll
                for (int i = 0; i < 16; ++i) {
                    const int ii = bt * 16 + i, rr = rr0 + ii, r = hf * HROWS + rr;
#pragma unroll
                    for (int e = 0; e < 4; ++e) nv[e] = bfs(nxt[i][e]);
                    float o[4];
#pragma unroll
                    for (int e = 0; e < 4; ++e) o[e] = pv[e] * cw[0][e] + cv[e] * cw[1][e] + nv[e] * cw[2][e];
                    if (tid < 128) { uint2 st; st.x = pk2(o[0], o[1]); st.y = pk2(o[2], o[3]); *(uint2*)(BIG + (size_t)r * LDB + C_RKV + ch) = st; }
                    else if (tid < 256) {
                        uint2 st; st.x = pk2(o[0], o[1]); st.y = pk2(o[2], o[3]); *(uint2*)(BIG + (size_t)r * LDB + C_RKV + ch) = st;
                        float sq = 0.f;
#pragma unroll
                        for (int e = 0; e < 4; ++e) { const float kq = o[e] * kkw[e]; sq += kq * kq; }
                        sq += __shfl_xor(sq, 1); sq += __shfl_xor(sq, 2); sq += __shfl_xor(sq, 4); sq += __shfl_xor(sq, 8);
                        if ((tid & 15) == 0) RINV[(size_t)r * 8 + ((tid - 128) >> 4)] = rsqrtf(sq + 1e-12f);
                    } else if (tid < 384) {
                        if (l == 0) { uint2 st; st.x = pk2(o[0], o[1]); st.y = pk2(o[2], o[3]); *(uint2*)(V0 + (size_t)r * 512 + ch - 1024) = st; }
                        else {
                            float z[4] = {vb[0], vb[1], vb[2], vb[3]};
                            const bf16_t* hdl = lt + 8192 + ii * 32;
#pragma unroll
                            for (int jq = 0; jq < 4; ++jq) { const bf16x8 hd = *(const bf16x8*)(hdl + jq * 8);
#pragma unroll
                                for (int j = 0; j < 8; ++j) { const float hv = bfs(hd[j]); const f32x4 uu = *(const f32x4*)(upl + (jq * 8 + j) * 512 + ch - 1024);
#pragma unroll
                                    for (int e = 0; e < 4; ++e) z[e] += hv * uu[e]; } }
#pragma unroll
                            for (int e = 0; e < 4; ++e) o[e] = o[e] + (bfs(vfs[i][e]) - o[e]) * sigm(z[e]);
                        }
                        uint2 st; st.x = pk2(o[0], o[1]); st.y = pk2(o[2], o[3]); *(uint2*)(BIG + (size_t)r * LDB + C_RKV + ch) = st;
                    } else {
                        const int ac = ch - 1536;
#pragma unroll
                        for (int e = 0; e < 4; ++e) { if (ac < 64) o[e] = 1.0f - 2.0f * __builtin_amdgcn_rcpf(1.0f + __expf(2.0f * o[e])); else if (ac >= 128) o[e] = sigm(o[e]); }
                        uint2 st; st.x = pk2(o[0], o[1]); st.y = pk2(o[2], o[3]); *(uint2*)(AL + (size_t)r * 256 + ac) = st;
                    }
#pragma unroll
                    for (int e = 0; e < 4; ++e) { pv[e] = cv[e]; cv[e] = nv[e]; }
                }
            }
        }
        __syncthreads();
    }
}

__device__ __forceinline__ void scan_block(PREF p, int l) {
    unsigned char* ws = p.ws; const int tid = ltid(), lane = tid & 63, wave = tid >> 6;
    const int s2 = lbid(), s = s2 >> 1, rhalf = s2 & 1, d = s >> 6, b = (s >> 3) & 7, h = s & 7;
    const bf16_t* BIG = (const bf16_t*)(ws + OFF_BIG); const bf16_t* AL = (const bf16_t*)(ws + OFF_AL); const float* RINV = (const float*)(ws + OFF_RINV);
    bf16_t* Y = (bf16_t*)(ws + OFF_B + B_Y) + (size_t)d * NROW * 512;
    float* stg = (float*)smem;
    const int NC = 136;
    f32x4 Sa = zf4(), Sb = zf4();
    const int rp = lane >> 3, kq = lane & 7, v0 = 32 * rhalf + 8 * (wave & 3) + rp;
    const int lt = tid - 256, lw = (lt >> 6) & 3, c16 = lane & 15, quad = lane >> 4, chn = 16 * lw + c16, chg = h * 64 + chn;
    const int sidx1 = (lt >> 3) & 31, cg8 = lt & 7;
    bf16x8 bw[2], ba[2]; float w0c = 0.f, a0c = 0.f, kkc = 0.f, kac = 0.f, kk8[8];
    {   const bf16_t* wwa = (const bf16_t*)(ws + OFF_WWA);
        for (int ks = 0; ks < 2; ++ks) { bw[ks] = *(const bf16x8*)(wwa + (size_t)((d * 2 + 0) * 512 + chg) * 64 + ks * 32 + quad * 8); ba[ks] = *(const bf16x8*)(wwa + (size_t)((d * 2 + 1) * 512 + chg) * 64 + ks * 32 + quad * 8); }
        w0c = p.rwkv_w0[(l * 2 + d) * 512 + chg]; a0c = p.rwkv_a0[(l * 2 + d) * 512 + chg]; kkc = p.rwkv_k_k[l * 512 + chg]; kac = p.rwkv_k_a[l * 512 + chg];
#pragma unroll
        for (int e = 0; e < 8; ++e) kk8[e] = p.rwkv_k_k[l * 512 + h * 64 + cg8 * 8 + e]; }
    bf16x8 Lr8, Lk8, Lv8, Lxw[2][2], Lxa[2][2]; float Lrinv = 0.f, Lri2[2][4]; bf16_t Lkf[2][4];
    auto issue = [&](int ci) {
        const int isl = ci >= 8, i0 = isl ? (ci - 8) * 32 : ci * 32, T = isl ? 4096 : 256, seg = isl ? seg_lat(b) : seg_ctx(b);
        {   const int i = i0 + sidx1, row = seg + (d ? T - 1 - i : i);
            const bf16_t* rb = BIG + (size_t)row * LDB + C_RKV + h * 64 + cg8 * 8;
            Lr8 = *(const bf16x8*)rb; Lk8 = *(const bf16x8*)(rb + 512); Lv8 = *(const bf16x8*)(rb + 1024); Lrinv = RINV[(size_t)row * 8 + h]; }
#pragma unroll
        for (int m = 0; m < 2; ++m) {
            const int iA = i0 + m * 16 + c16, rowA = seg + (d ? T - 1 - iA : iA);
#pragma unroll
            for (int ks = 0; ks < 2; ++ks) { Lxw[m][ks] = *(const bf16x8*)(AL + (size_t)rowA * 256 + ks * 32 + quad * 8); Lxa[m][ks] = *(const bf16x8*)(AL + (size_t)rowA * 256 + 64 + ks * 32 + quad * 8); }
#pragma unroll
            for (int e = 0; e < 4; ++e) { const int i = i0 + m * 16 + quad * 4 + e, row = seg + (d ? T - 1 - i : i);
                Lkf[m][e] = BIG[(size_t)row * LDB + C_RKV + 512 + chg]; Lri2[m][e] = RINV[(size_t)row * 8 + h]; }
        }
    };
    auto finish = [&](float* buf) {
        {   float* base = buf + sidx1 * 384 + cg8 * 8; f32x4 t0, t1;
#pragma unroll
            for (int e = 0; e < 4; ++e) { t0[e] = -bfs(Lk8[e]) * kk8[e] * Lrinv; t1[e] = -bfs(Lk8[4 + e]) * kk8[4 + e] * Lrinv; }
            *(f32x4*)(base) = t0; *(f32x4*)(base + 4) = t1;
#pragma unroll
            for (int e = 0; e < 4; ++e) { t0[e] = bfs(Lr8[e]); t1[e] = bfs(Lr8[4 + e]); }
            *(f32x4*)(base + 256) = t0; *(f32x4*)(base + 260) = t1;
#pragma unroll
            for (int e = 0; e < 4; ++e) { t0[e] = bfs(Lv8[e]); t1[e] = bfs(Lv8[4 + e]); }
            *(f32x4*)(base + 320) = t0; *(f32x4*)(base + 324) = t1;
        }
#pragma unroll
        for (int m = 0; m < 2; ++m) {
            f32x4 aw = zf4(), aa = zf4();
#pragma unroll
            for (int ks = 0; ks < 2; ++ks) { aw = __builtin_amdgcn_mfma_f32_16x16x32_bf16(Lxw[m][ks], bw[ks], aw, 0, 0, 0); aa = __builtin_amdgcn_mfma_f32_16x16x32_bf16(Lxa[m][ks], ba[ks], aa, 0, 0, 0); }
#pragma unroll
            for (int e = 0; e < 4; ++e) { const int si = m * 16 + quad * 4 + e;
                const float kf = bf2f(Lkf[m][e]), rinv = Lri2[m][e];
                const float dec = __expf(-0.6065306597f * sigm(w0c + aw[e])), as = sigm(a0c + aa[e]);
                float* base = buf + si * 384 + chn; base[64] = dec; base[128] = kf * (1.0f + (as - 1.0f) * kac); base[192] = kf * kkc * rinv * as; }
        }
    };
    if (wave >= 4) { issue(0); finish(stg); issue(1); }

    __syncthreads();
    for (int ci = 0; ci < NC; ++ci) {
        float* buf = stg + (ci & 1) * (32 * 384);
        if (wave < 4) {
            const int isl = ci >= 8, i0 = isl ? (ci - 8) * 32 : ci * 32, T = isl ? 4096 : 256, seg = isl ? seg_lat(b) : seg_ctx(b);
            const float* base0 = buf + kq * 8;
            f32x4 oa0, oa1, ow0, ow1, ok0, ok1, ob0, ob1, or0, or1; float ov;
            f32x4 na0, na1, nw0, nw1, nk0, nk1, nb0, nb1, nr0, nr1; float nv;
#define SC_LOAD(P, st_) do { const float* bs_ = base0 + (st_) * 384; P##a0 = *(const f32x4*)(bs_); P##a1 = *(const f32x4*)(bs_ + 4); P##w0 = *(const f32x4*)(bs_ + 64); P##w1 = *(const f32x4*)(bs_ + 68); \
                P##k0 = *(const f32x4*)(bs_ + 128); P##k1 = *(const f32x4*)(bs_ + 132); P##b0 = *(const f32x4*)(bs_ + 192); P##b1 = *(const f32x4*)(bs_ + 196); \
                P##r0 = *(const f32x4*)(bs_ + 256); P##r1 = *(const f32x4*)(bs_ + 260); P##v = buf[(st_) * 384 + 320 + v0]; } while (0)
#define SC_STEP(P, st_) do { f32x4 t_ = Sa * P##a0 + Sb * P##a1; float sa_ = (t_[0] + t_[1]) + (t_[2] + t_[3]); sa_ = red8(sa_); \
                Sa = Sa * P##w0 + (P##b0 * sa_ + P##k0 * P##v); Sb = Sb * P##w1 + (P##b1 * sa_ + P##k1 * P##v); \
                f32x4 u_ = Sa * P##r0 + Sb * P##r1; float y_ = (u_[0] + u_[1]) + (u_[2] + u_[3]); y_ = red8(y_); \
                if (kq == 0) { const int i_ = i0 + (st_), row_ = seg + (d ? T - 1 - i_ : i_); Y[(size_t)row_ * 512 + h * 64 + v0] = f2bf(y_); } } while (0)
            SC_LOAD(o, 0);
            for (int st = 0; st < 32; st += 2) {
                SC_LOAD(n, st + 1);
                SC_STEP(o, st);
                if (st + 2 < 32) SC_LOAD(o, st + 2);
                SC_STEP(n, st + 1);
            }
#undef SC_LOAD
#undef SC_STEP
        } else if (ci + 1 < NC) { finish(stg + ((ci + 1) & 1) * (32 * 384)); if (ci + 2 < NC) issue(ci + 2); }
        __syncthreads();
    }
}

#define MF16(a, b, c) __builtin_amdgcn_mfma_f32_16x16x16bf16_1k(a, b, c, 0, 0, 0)
#define LDS_SYNC() asm volatile("s_waitcnt lgkmcnt(0)" ::: "memory")
__device__ __forceinline__ bf16x4 pk4(f32x4 v) { u32x2 r; r[0] = cvtpk(v[0], v[1]); r[1] = cvtpk(v[2], v[3]); return __builtin_bit_cast(bf16x4, r); }
__device__ __forceinline__ f32x4 mm16(const bf16_t* A, int lda, const bf16_t* B, int ldb, int K, f32x4 acc, int c16, int quad) {
    for (int kk = 0; kk < K; kk += 16) { const bf16x4 a = *(const bf16x4*)(A + c16 * lda + kk + quad * 4), b = *(const bf16x4*)(B + c16 * ldb + kk + quad * 4); acc = MF16(a, b, acc); }
    return acc;
}
constexpr int SC_PS = 68, SC_M = 16 * SC_PS, SC_SLOT = 11776, SC_SCR = 10752, SC_NL = 4, SC_NCH = 272;
__device__ __forceinline__ void scan_chunked(PREF p, int l) {
    unsigned char* ws = p.ws; const int tid = ltid(), lane = tid & 63, wave = tid >> 6, c16 = lane & 15, quad = lane >> 4;
    const int s = lbid(), d = s >> 6, b = (s >> 3) & 7, h = s & 7;
    const bf16_t* BIG = (const bf16_t*)(ws + OFF_BIG); const bf16_t* AL = (const bf16_t*)(ws + OFF_AL); const float* RINV = (const float*)(ws + OFF_RINV);
    bf16_t* Y = (bf16_t*)(ws + OFF_B + B_Y) + (size_t)d * NROW * 512;
    unsigned char* slots = smem; unsigned char* scr = smem + 2 * SC_NL * SC_SLOT + ((wave >= 2 && wave < 2 + SC_NL) ? (wave - 2) : 0) * SC_SCR;
    bf16_t* AH = (bf16_t*)scr; bf16_t* RH = AH + SC_M; bf16_t* BC = RH + SC_M; bf16_t* KC = BC + SC_M; bf16_t* AHT = KC + SC_M; float* LF = (float*)BC;
    bf16_t* TB = KC; bf16_t* AKT = TB + 256; bf16_t* ARB = AKT + 256;
    bf16_t* WL = (bf16_t*)(smem + 2 * SC_NL * SC_SLOT + SC_NL * SC_SCR);
    {   const bf16_t* wwa = (const bf16_t*)(ws + OFF_WWA);
        for (int i = tid; i < 1024; i += 512) { const int wa = i >> 9, ch = (i >> 3) & 63, q8 = i & 7;
            *(uint4*)(WL + ((wa * 64 + ch) * 72 + q8 * 8)) = *(const uint4*)(wwa + (size_t)((d * 2 + wa) * 512 + h * 64 + ch) * 64 + q8 * 8); } }
    bf16x4 Pr[4], Pk[4]; bf16x8 Pxw[2], Pxa[2], Pv[2]; float Prinv = 0.f;
    auto rowof = [&](int c, int tk) -> int { const int isl = c >= 16, i = (isl ? (c - 16) * 16 : c * 16) + tk, T = isl ? 4096 : 256; return (isl ? seg_lat(b) : seg_ctx(b)) + (d ? T - 1 - i : i); };
    auto issue = [&](int c) {
        const int row = rowof(c, c16); const bf16_t* rb = BIG + (size_t)row * LDB + C_RKV + h * 64 + quad * 4;
#pragma unroll
        for (int nt = 0; nt < 4; ++nt) { Pr[nt] = *(const bf16x4*)(rb + nt * 16); Pk[nt] = *(const bf16x4*)(rb + 512 + nt * 16); }
        Prinv = RINV[(size_t)row * 8 + h];
#pragma unroll
        for (int ks = 0; ks < 2; ++ks) { Pxw[ks] = *(const bf16x8*)(AL + (size_t)row * 256 + ks * 32 + quad * 8); Pxa[ks] = *(const bf16x8*)(AL + (size_t)row * 256 + 64 + ks * 32 + quad * 8); }
        { const bf16_t* vp = BIG + (size_t)rowof(c, lane >> 2) * LDB + C_RKV + 1024 + h * 64 + (lane & 3) * 16; Pv[0] = *(const bf16x8*)vp; Pv[1] = *(const bf16x8*)(vp + 8); }
    };
    auto build = [&](unsigned char* slot) {
        bf16_t* sW1 = (bf16_t*)slot; bf16_t* sQ1 = sW1 + SC_M; bf16_t* sA2 = sQ1 + SC_M; bf16_t* sA3 = sA2 + 256; bf16_t* sBT = sA3 + 256; bf16_t* sKT = sBT + 1024; float* sG = (float*)(sKT + 1024); bf16_t* sVT = (bf16_t*)(sG + 64);
#pragma unroll
        for (int e = 0; e < 8; ++e) { sVT[((lane & 3) * 16 + e) * 16 + (lane >> 2)] = (bf16_t)Pv[0][e]; sVT[((lane & 3) * 16 + 8 + e) * 16 + (lane >> 2)] = (bf16_t)Pv[1][e]; }
#pragma unroll
        for (int nt = 0; nt < 4; ++nt) {
            f32x4 aw = zf4(), aa = zf4();
#pragma unroll
            for (int ks = 0; ks < 2; ++ks) { const bf16x8 fw = *(const bf16x8*)(WL + ((nt * 16 + c16) * 72 + ks * 32 + quad * 8)), fa = *(const bf16x8*)(WL + ((64 + nt * 16 + c16) * 72 + ks * 32 + quad * 8));
                aw = __builtin_amdgcn_mfma_f32_16x16x32_bf16(fw, Pxw[ks], aw, 0, 0, 0); aa = __builtin_amdgcn_mfma_f32_16x16x32_bf16(fa, Pxa[ks], aa, 0, 0, 0); }
            const int ch0 = nt * 16 + quad * 4, cg = h * 64 + ch0;
            const f32x4 w0v = *(const f32x4*)(p.rwkv_w0 + (l * 2 + d) * 512 + cg), a0v = *(const f32x4*)(p.rwkv_a0 + (l * 2 + d) * 512 + cg), kkv = *(const f32x4*)(p.rwkv_k_k + l * 512 + cg), kav = *(const f32x4*)(p.rwkv_k_a + l * 512 + cg);
            f32x4 vAH, vRH, vBC, vKC;
#pragma unroll
            for (int e = 0; e < 4; ++e) {
                const float lw = -0.6065306597f * sigm(w0v[e] + aw[e]);
                float g = lw;
                g += __int_as_float(__builtin_amdgcn_update_dpp(0, __float_as_int(g), 0x111, 0xF, 0xF, true));
                g += __int_as_float(__builtin_amdgcn_update_dpp(0, __float_as_int(g), 0x112, 0xF, 0xF, true));
                g += __int_as_float(__builtin_amdgcn_update_dpp(0, __float_as_int(g), 0x114, 0xF, 0xF, true));
                g += __int_as_float(__builtin_amdgcn_update_dpp(0, __float_as_int(g), 0x118, 0xF, 0xF, true));
                const float g15 = __shfl(g, (lane & 48) | 15), gm1 = g - lw;
                const float as = sigm(a0v[e] + aa[e]), kf = bfs(Pk[nt][e]), rf = bfs(Pr[nt][e]), kk = kf * kkv[e] * Prinv;
                const float bv = kk * as, kd = kf * (1.0f + (as - 1.0f) * kav[e]);
                const float eg = __expf(g), egm1 = __expf(gm1), eng = __expf(-g), etl = __expf(g15 - g);
                vAH[e] = -kk * egm1; vRH[e] = rf * eg; vBC[e] = bv * eng; vKC[e] = kd * eng;
                AHT[(ch0 + e) * 16 + c16] = f2bf(vAH[e]); sBT[(ch0 + e) * 16 + c16] = f2bf(bv * etl); sKT[(ch0 + e) * 16 + c16] = f2bf(kd * etl);
                if (c16 == 15) sG[ch0 + e] = eg;
            }
            *(bf16x4*)(AH + c16 * SC_PS + ch0) = pk4(vAH); *(bf16x4*)(RH + c16 * SC_PS + ch0) = pk4(vRH); *(bf16x4*)(BC + c16 * SC_PS + ch0) = pk4(vBC); *(bf16x4*)(KC + c16 * SC_PS + ch0) = pk4(vKC);
        }
        LDS_SYNC();
        f32x4 Lab = mm16(BC, SC_PS, AH, SC_PS, 64, zf4(), c16, quad);
        f32x4 Lak = mm16(AH, SC_PS, KC, SC_PS, 64, zf4(), c16, quad);
        f32x4 Lrb = mm16(BC, SC_PS, RH, SC_PS, 64, zf4(), c16, quad);
        f32x4 Lrk = mm16(KC, SC_PS, RH, SC_PS, 64, zf4(), c16, quad);
        LDS_SYNC();
#pragma unroll
        for (int e = 0; e < 4; ++e) { const int tq = quad * 4 + e; if (!(tq < c16)) Lab[e] = 0.f; if (!(c16 < tq)) Lak[e] = 0.f; if (!(tq <= c16)) { Lrb[e] = 0.f; Lrk[e] = 0.f; } }
        *(f32x4*)(LF + c16 * 16 + quad * 4) = Lab;
        *(bf16x4*)(AKT + c16 * 16 + quad * 4) = pk4(Lak);
        *(bf16x4*)(ARB + c16 * 16 + quad * 4) = pk4(Lrb);
        LDS_SYNC();
        {   float Tc[16];
#pragma unroll
            for (int i = 0; i < 16; ++i) { float acc0 = (i == c16) ? 1.0f : 0.0f, acc1 = 0.f;
                f32x4 lv[4];
#pragma unroll
                for (int s4 = 0; s4 < 4; ++s4) lv[s4] = (s4 * 4 < i) ? *(const f32x4*)(LF + i * 16 + s4 * 4) : (f32x4){0.f, 0.f, 0.f, 0.f};
#pragma unroll
                for (int sI = 0; sI < 16; ++sI) { if (sI < i) { if (sI & 1) acc1 += lv[sI >> 2][sI & 3] * Tc[sI]; else acc0 += lv[sI >> 2][sI & 3] * Tc[sI]; } }
                Tc[i] = acc0 + acc1; }
            if (quad == 0) {
#pragma unroll
                for (int i = 0; i < 16; ++i) TB[i * 16 + c16] = f2bf(Tc[i]); }
        }
        LDS_SYNC();
        const bf16x4 arb = *(const bf16x4*)(ARB + c16 * 16 + quad * 4);
#pragma unroll
        for (int nt = 0; nt < 4; ++nt) {
            const f32x4 w1b = mm16(AHT + nt * 256, 16, TB, 16, 16, zf4(), c16, quad);
            *(bf16x4*)(sW1 + c16 * SC_PS + nt * 16 + quad * 4) = pk4(w1b);
            const bf16x4 w1a = pk4(mm16(TB, 16, AHT + nt * 256, 16, 16, zf4(), c16, quad));
            const bf16x4 rh = *(const bf16x4*)(RH + c16 * SC_PS + nt * 16 + quad * 4); f32x4 q1;
#pragma unroll
            for (int e = 0; e < 4; ++e) q1[e] = bfs(rh[e]);
            q1 = MF16(w1a, arb, q1);
            *(bf16x4*)(sQ1 + c16 * SC_PS + nt * 16 + quad * 4) = pk4(q1);
        }
        {   const bf16x4 a2a = pk4(mm16(TB, 16, AKT, 16, 16, zf4(), c16, quad));
            const f32x4 a2b = mm16(AKT, 16, TB, 16, 16, zf4(), c16, quad);
            *(bf16x4*)(sA2 + c16 * 16 + quad * 4) = pk4(a2b);
            const f32x4 a3 = MF16(a2a, arb, Lrk);
            *(bf16x4*)(sA3 + c16 * 16 + quad * 4) = pk4(a3); }
        LDS_SYNC();
    };
    f32x4 Hc[2][4];
#pragma unroll
    for (int sl = 0; sl < 2; ++sl)
#pragma unroll
        for (int kt = 0; kt < 4; ++kt) Hc[sl][kt] = zf4();
    auto consume = [&](int c, const unsigned char* slot) {
        const bf16_t* sW1 = (const bf16_t*)slot; const bf16_t* sQ1 = sW1 + SC_M; const bf16_t* sA2 = sQ1 + SC_M; const bf16_t* sA3 = sA2 + 256; const bf16_t* sBT = sA3 + 256; const bf16_t* sKT = sBT + 1024; const float* sG = (const float*)(sKT + 1024); const bf16_t* sVT = (const bf16_t*)(sG + 64);
        bf16x4 vb[2]; f32x4 aU[2], aY[2];
#pragma unroll
        for (int sl = 0; sl < 2; ++sl) { vb[sl] = *(const bf16x4*)(sVT + (32 * wave + 16 * sl + c16) * 16 + quad * 4); aU[sl] = zf4(); aY[sl] = zf4(); }
#pragma unroll
        for (int kt = 0; kt < 4; ++kt) { const bf16x4 w1f = *(const bf16x4*)(sW1 + c16 * SC_PS + kt * 16 + quad * 4), q1f = *(const bf16x4*)(sQ1 + c16 * SC_PS + kt * 16 + quad * 4);
#pragma unroll
            for (int sl = 0; sl < 2; ++sl) { const bf16x4 hb = pk4(Hc[sl][kt]); aU[sl] = MF16(w1f, hb, aU[sl]); aY[sl] = MF16(q1f, hb, aY[sl]); } }
        { const bf16x4 a2f = *(const bf16x4*)(sA2 + c16 * 16 + quad * 4), a3f = *(const bf16x4*)(sA3 + c16 * 16 + quad * 4);
#pragma unroll
          for (int sl = 0; sl < 2; ++sl) { aU[sl] = MF16(a2f, vb[sl], aU[sl]); aY[sl] = MF16(a3f, vb[sl], aY[sl]); } }
        bf16x4 ub[2];
#pragma unroll
        for (int sl = 0; sl < 2; ++sl) ub[sl] = pk4(aU[sl]);
#pragma unroll
        for (int kt = 0; kt < 4; ++kt) { const f32x4 gm = *(const f32x4*)(sG + kt * 16 + quad * 4);
            const bf16x4 bf = *(const bf16x4*)(sBT + (kt * 16 + c16) * 16 + quad * 4), kf = *(const bf16x4*)(sKT + (kt * 16 + c16) * 16 + quad * 4);
#pragma unroll
            for (int sl = 0; sl < 2; ++sl) { f32x4 hn = Hc[sl][kt] * gm; hn = MF16(bf, ub[sl], hn); hn = MF16(kf, vb[sl], hn); Hc[sl][kt] = hn; } }
#pragma unroll
        for (int e = 0; e < 4; ++e) { bf16_t* yp = Y + (size_t)rowof(c, quad * 4 + e) * 512 + h * 64 + 32 * wave + c16; yp[0] = f2bf(aY[0][e]); yp[16] = f2bf(aY[1][e]); }
    };
    const int NR = (SC_NCH + SC_NL - 1) / SC_NL;
    const bool isload = wave >= 2 && wave < 2 + SC_NL, iscomp = wave < 2;
    if (isload) issue(wave - 2);
    __syncthreads();
    for (int R = 0; R <= NR; ++R) {
        if (isload) { const int c = R * SC_NL + (wave - 2); if (c < SC_NCH) { build(slots + ((R & 1) * SC_NL + (wave - 2)) * SC_SLOT); if (c + SC_NL < SC_NCH) issue(c + SC_NL); } }
        else if (iscomp && R > 0) { for (int q = 0; q < SC_NL; ++q) { const int c = (R - 1) * SC_NL + q; if (c < SC_NCH) consume(c, slots + (((R - 1) & 1) * SC_NL + q) * SC_SLOT); } }
        __syncthreads();
    }
}

__device__ __forceinline__ void attn_item(PREF p, int l, int item) {
    unsigned char* ws = p.ws; const int tid = ltid(), lane = tid & 63, wave = tid >> 6, g = wave >> 1, hq = wave & 1, quad = lane >> 4, c16 = lane & 15;
    bf16_t* BIG = (bf16_t*)(ws + OFF_BIG); const bf16_t* vTl = (const bf16_t*)(ws + OFF_VT); const bf16_t* vTc = vTl + (size_t)8 * 128 * 4096;
    int b, qb = 0, kvh, q0, qrow0; bool latent;
    if (item < 512) { latent = true; b = item >> 6; qb = (item >> 1) & 31; kvh = item & 1; q0 = qb * 128 + 64 * hq; qrow0 = seg_lat(b) + q0; }
    else { const int it2 = item - 512; latent = false; b = it2 >> 2; kvh = (it2 >> 1) & 1; q0 = (it2 & 1) * 128 + 64 * hq; qrow0 = seg_ctx(b) + q0; }
    const int head = kvh * 4 + g; const float sink = p.attn_sink[l * 8 + head];
    int jlo = 0, nband = 0;
    if (latent) { jlo = hq > (qb == 0 ? 2 : 0) ? hq : (qb == 0 ? 2 : 0); const int jhi = (hq + 4) < (qb == 31 ? 3 : 5) ? (hq + 4) : (qb == 31 ? 3 : 5); nband = jhi - jlo + 1; }
    const int nblk = nband + 4;
    auto blk_k = [&](int i) -> const bf16_t* {
        const int krow0 = i < nband ? seg_lat(b) + qb * 128 - 128 + 64 * (jlo + i) : seg_ctx(b) + 64 * (i - nband);
        return BIG + (size_t)(krow0 + c16) * LDB + 512 + kvh * 64 + quad * 8; };
    auto blk_v = [&](int i) -> const bf16_t* {
        const bf16_t* vt = i < nband ? vTl + (size_t)((b * 2 + kvh) * 64 + ((qb * 128 - 128 + 64 * (jlo + i)) >> 6)) * 4096 : vTc + (size_t)((b * 2 + kvh) * 4 + (i - nband)) * 4096;
        return vt + c16 * 64 + quad * 4; };
    for (int qh = 0; qh < 2; ++qh) {
    const int qr = qrow0 + qh * 32, qq = q0 + qh * 32;
    bf16x8 qf[2][2];
#pragma unroll
    for (int qt = 0; qt < 2; ++qt)
#pragma unroll
        for (int ks = 0; ks < 2; ++ks) qf[qt][ks] = *(const bf16x8*)(BIG + (size_t)(qr + qt * 16 + c16) * LDB + head * 64 + ks * 32 + quad * 8);
    f32x4 o[4][2]; float mx[2], ls[2];
#pragma unroll
    for (int qt = 0; qt < 2; ++qt) { mx[qt] = sink; ls[qt] = quad == 0 ? 1.0f : 0.0f;
#pragma unroll
        for (int dt = 0; dt < 4; ++dt) o[dt][qt] = zf4(); }
    bf16x8 kf[4][2];
    { const bf16_t* kp = blk_k(0);
#pragma unroll
      for (int kt = 0; kt < 4; ++kt) { kf[kt][0] = *(const bf16x8*)(kp + (size_t)kt * 16 * LDB); kf[kt][1] = *(const bf16x8*)(kp + (size_t)kt * 16 * LDB + 32); } }
    for (int blk = 0; blk < nblk; ++blk) {
        const bool band = blk < nband; const int kp0 = qb * 128 - 128 + 64 * (jlo + blk);
        bf16x4 va[2][4], vb[2][4];
        { const bf16_t* vp = blk_v(blk);
#pragma unroll
          for (int kp2 = 0; kp2 < 2; ++kp2)
#pragma unroll
            for (int dt = 0; dt < 4; ++dt) { va[kp2][dt] = *(const bf16x4*)(vp + dt * 16 * 64 + kp2 * 32); vb[kp2][dt] = *(const bf16x4*)(vp + dt * 16 * 64 + kp2 * 32 + 16); } }
        f32x4 s[4][2];
#pragma unroll
        for (int kt = 0; kt < 4; ++kt)
#pragma unroll
            for (int qt = 0; qt < 2; ++qt) { f32x4 a = zf4(); a = __builtin_amdgcn_mfma_f32_16x16x32_bf16(kf[kt][0], qf[qt][0], a, 0, 0, 0); a = __builtin_amdgcn_mfma_f32_16x16x32_bf16(kf[kt][1], qf[qt][1], a, 0, 0, 0); s[kt][qt] = a; }
        if (blk + 1 < nblk) { const bf16_t* kp = blk_k(blk + 1);
#pragma unroll
            for (int kt = 0; kt < 4; ++kt) { kf[kt][0] = *(const bf16x8*)(kp + (size_t)kt * 16 * LDB); kf[kt][1] = *(const bf16x8*)(kp + (size_t)kt * 16 * LDB + 32); } }
        if (band) {
#pragma unroll
            for (int kt = 0; kt < 4; ++kt)
#pragma unroll
                for (int qt = 0; qt < 2; ++qt)
#pragma unroll
                    for (int e = 0; e < 4; ++e) { const int dl = (kp0 + kt * 16 + quad * 4 + e) - (qq + qt * 16 + c16); if (dl > 128 || dl < -128) s[kt][qt][e] = -1e30f; }
        }
#pragma unroll
        for (int qt = 0; qt < 2; ++qt) {
            float m2 = s[0][qt][0];
#pragma unroll
            for (int kt = 0; kt < 4; ++kt)
#pragma unroll
                for (int e = 0; e < 4; ++e) m2 = fmaxf(m2, s[kt][qt][e]);
            m2 = fmaxf(m2, __shfl_xor(m2, 16)); m2 = fmaxf(m2, __shfl_xor(m2, 32));
            const float mn = fmaxf(mx[qt], m2), al = __expf(mx[qt] - mn); mx[qt] = mn; float lsum = ls[qt] * al;
#pragma unroll
            for (int dt = 0; dt < 4; ++dt) o[dt][qt] *= al;
#pragma unroll
            for (int kt = 0; kt < 4; ++kt)
#pragma unroll
                for (int e = 0; e < 4; ++e) { const float pe = __expf(s[kt][qt][e] - mn); lsum += pe; s[kt][qt][e] = pe; }
            ls[qt] = lsum;
        }
#pragma unroll
        for (int kp2 = 0; kp2 < 2; ++kp2) {
            bf16x8 pb[2];
#pragma unroll
            for (int qt = 0; qt < 2; ++qt)
#pragma unroll
                for (int e = 0; e < 4; ++e) { pb[qt][e] = (short)f2bf(s[2 * kp2][qt][e]); pb[qt][4 + e] = (short)f2bf(s[2 * kp2 + 1][qt][e]); }
#pragma unroll
            for (int dt = 0; dt < 4; ++dt) {
                bf16x8 vf; vf[0] = va[kp2][dt][0]; vf[1] = va[kp2][dt][1]; vf[2] = va[kp2][dt][2]; vf[3] = va[kp2][dt][3]; vf[4] = vb[kp2][dt][0]; vf[5] = vb[kp2][dt][1]; vf[6] = vb[kp2][dt][2]; vf[7] = vb[kp2][dt][3];
#pragma unroll
                for (int qt = 0; qt < 2; ++qt) o[dt][qt] = __builtin_amdgcn_mfma_f32_16x16x32_bf16(vf, pb[qt], o[dt][qt], 0, 0, 0);
            }
        }
    }
#pragma unroll
    for (int qt = 0; qt < 2; ++qt) {
        float lt = ls[qt]; lt += __shfl_xor(lt, 16); lt += __shfl_xor(lt, 32); const float inv = __builtin_amdgcn_rcpf(lt);
#pragma unroll
        for (int dt = 0; dt < 4; ++dt) st_bf4(BIG + (size_t)(qr + qt * 16 + c16) * LDB + head * 64 + dt * 16 + quad * 4, o[dt][qt] * inv);
    }
    }
}

__device__ __forceinline__ void sgu_tile(PREF p, int l, int tile) {
    unsigned char* ws = p.ws; const int tid = ltid(), lane = tid & 63, w = tid >> 6, quad = lane >> 4, c16 = lane & 15;
    const int n = tile >> 2, g = tile & 3, row0 = n * 128;
    bf16_t* BIG = (bf16_t*)(ws + OFF_BIG); const bf16_t* vnT = (const bf16_t*)(ws + OFF_VNT); const bf16_t* wsg = (const bf16_t*)(ws + OFF_WSGU);
    f32x4 acc[8];
#pragma unroll
    for (int i = 0; i < 8; ++i) acc[i] = zf4();
    const bf16_t* ap = wsg + (size_t)((g * 128 + 16 * w + c16) * 128) + quad * 8;
    const bf16_t* bp = vnT + ((size_t)n * 512 + g * 128 + c16) * 128 + quad * 8;
    bf16x8 afr[4], bcur[8], bnxt[8];
#pragma unroll
    for (int ks = 0; ks < 4; ++ks) afr[ks] = *(const bf16x8*)(ap + ks * 32);
#pragma unroll
    for (int nt = 0; nt < 8; ++nt) bcur[nt] = *(const bf16x8*)(bp + (size_t)nt * 16 * 128);
    const int pl0 = 16 * w + c16;
    bf16x4 olds[8];
#pragma unroll
    for (int nt = 0; nt < 8; ++nt) olds[nt] = *(const bf16x4*)(BIG + (size_t)(row0 + pl0) * LDB + C_SGU + g * 128 + nt * 16 + quad * 4);
#pragma unroll
    for (int ks = 0; ks < 4; ++ks) {
        if (ks < 3) {
#pragma unroll
            for (int nt = 0; nt < 8; ++nt) bnxt[nt] = *(const bf16x8*)(bp + (size_t)nt * 16 * 128 + (ks + 1) * 32); }
#pragma unroll
        for (int nt = 0; nt < 8; ++nt) acc[nt] = __builtin_amdgcn_mfma_f32_16x16x32_bf16(bcur[nt], afr[ks], acc[nt], 0, 0, 0);
#pragma unroll
        for (int nt = 0; nt < 8; ++nt) bcur[nt] = bnxt[nt];
    }
    const int pl = 16 * w + c16; const float bias = p.sgu_b[l * 512 + g * 128 + pl];
#pragma unroll
    for (int nt = 0; nt < 8; ++nt) { bf16_t* q = BIG + (size_t)(row0 + pl) * LDB + C_SGU + g * 128 + nt * 16 + quad * 4; const bf16x4 old = olds[nt]; f32x4 v;
#pragma unroll
        for (int e = 0; e < 4; ++e) v[e] = bfs(old[e]) * (acc[nt][e] + bias);
        st_bf4(q, v); }
}
__device__ __forceinline__ void phase_attn(PREF p, int l) {
    const int nb = gridDim.x - 128, bid = lbid() - 128; const int nAttn = l == 1 ? 512 : 544;
    for (int it = bid; it < nAttn; it += nb) attn_item(p, l, it);
}
__device__ __forceinline__ void phase_sgu(PREF p, int l) {
    const int nb = gridDim.x - 128, bid = lbid() - 128; const bool last = l == 1;
    for (int tile = bid; tile < 1088; tile += nb) { const int n = tile >> 2; if (last && ((n * 128) % HROWS) >= 16384) continue; sgu_tile(p, l, tile); }
}

__device__ __forceinline__ void phase_post(PREF p, int l) {
    unsigned char* ws = p.ws; const int lane = ltid() & 63, gw = lbid() * 8 + (ltid() >> 6); const bool last = l == 1;
    bf16_t* BIG = (bf16_t*)(ws + OFF_BIG); const bf16_t* Gb = (const bf16_t*)(ws + OFF_B + B_G); const bf16_t* AS = (const bf16_t*)(ws + OFF_B + B_ASUM);
    const bf16_t* Y0 = (const bf16_t*)(ws + OFF_B + B_Y); const bf16_t* Y1 = Y0 + (size_t)NROW * 512;
    const int c = lane * 8;
    float lw[8], lb[8], rk[8], ka[8];
#pragma unroll
    for (int e = 0; e < 8; ++e) { lw[e] = p.rwkv_ln_w[l * 512 + c + e]; lb[e] = p.rwkv_ln_b[l * 512 + c + e]; rk[e] = p.rwkv_r_k[l * 512 + c + e]; ka[e] = p.rwkv_k_a[l * 512 + c + e]; }
    const int nw = gridDim.x * 8;
    for (int rb0 = gw; rb0 < NROW; rb0 += 4 * nw) {
        bf16x8 y0s[4], y1s[4], ggs[4], ass[4], r8s[4], k8s[4], v8s[4]; bool act[4];
#pragma unroll
        for (int k = 0; k < 4; ++k) { int r = rb0 + k * nw; act[k] = r < NROW && !(last && (r % HROWS) >= 16384); if (!act[k]) r = rb0;
            y0s[k] = *(const bf16x8*)(Y0 + (size_t)r * 512 + c); y1s[k] = *(const bf16x8*)(Y1 + (size_t)r * 512 + c); ggs[k] = *(const bf16x8*)(Gb + (size_t)r * 512 + c); ass[k] = *(const bf16x8*)(AS + (size_t)r * 512 + c);
            const bf16_t* rb = BIG + (size_t)r * LDB + C_RKV + c; r8s[k] = *(const bf16x8*)rb; k8s[k] = *(const bf16x8*)(rb + 512); v8s[k] = *(const bf16x8*)(rb + 1024); }
#pragma unroll
        for (int k = 0; k < 4; ++k) {
            const int r = rb0 + k * nw;
            const bf16x8 y0 = y0s[k], y1 = y1s[k], gg = ggs[k], as = ass[k], r8 = r8s[k], k8 = k8s[k], v8 = v8s[k];
            float y[8], s1 = 0.f, bo = 0.f;
#pragma unroll
            for (int e = 0; e < 8; ++e) { y[e] = bfs(y0[e]) + bfs(y1[e]); s1 += y[e]; bo += bfs(r8[e]) * bfs(k8[e]) * rk[e] * (2.0f + (bfs(as[e]) - 2.0f) * ka[e]); }
            s1 += __shfl_xor(s1, 1); s1 += __shfl_xor(s1, 2); s1 += __shfl_xor(s1, 4);
            bo += __shfl_xor(bo, 1); bo += __shfl_xor(bo, 2); bo += __shfl_xor(bo, 4);
            const float mu = s1 * (1.0f / 64.0f); float s2 = 0.f;
#pragma unroll
            for (int e = 0; e < 8; ++e) { y[e] -= mu; s2 += y[e] * y[e]; }
            s2 += __shfl_xor(s2, 1); s2 += __shfl_xor(s2, 2); s2 += __shfl_xor(s2, 4);
            const float rstd = rsqrtf(s2 * (1.0f / 64.0f) + 64e-5f);
            float o[8];
#pragma unroll
            for (int e = 0; e < 8; ++e) o[e] = (y[e] * rstd * lw[e] + lb[e] + bo * bfs(v8[e])) * bfs(gg[e]);
            uint4 st; st.x = pk2(o[0], o[1]); st.y = pk2(o[2], o[3]); st.z = pk2(o[4], o[5]); st.w = pk2(o[6], o[7]);
            if (act[k]) *(uint4*)(BIG + (size_t)r * LDB + C_RKV + c) = st;
        }
    }
}

#define KP (*kargs())
#ifndef PROBE_ID
#define PROBE_ID -1
#endif
#ifndef PROBE_L
#define PROBE_L 0
#endif
#define TS(k) do { if (PROBE_ID >= 0 && l == PROBE_L) { if ((k) == PROBE_ID) tA = wall_clock64(); if ((k) == PROBE_ID + 1) tB = wall_clock64(); } } while (0)
__global__ __launch_bounds__(512) void mega(P pdummy) {
    cg::grid_group grid = cg::this_grid();
    LAS unsigned char* lds = (LAS unsigned char*)smem;
    unsigned long long tA = 0, tB = 0;
    for (int l = 0; l < 2; ++l) {
        const bool last = l == 1;
        TS(0);
        phase_W(KP, l); grid.sync(); TS(1);
        { unsigned char* ws = kargs()->ws; phase_norm(KP, l, 0, 0, HROWS, (bf16_t*)(ws + OFF_B + B_HH), l == 0, false); } grid.sync();
        for (int hf = 0; hf < 2; ++hf) {
            {   unsigned char* ws = kargs()->ws;
                Gemm g; g.A = (const bf16_t*)(ws + OFF_B + B_HH); g.Bt = (const bf16_t*)(ws + OFF_WIN1); g.lda = 1024; g.ldb = 1024; g.K = 1024; g.perm = true;
                SchedStd S; S.init(68, last ? 15 : 14, 0);
                EpiIn E; E.qkv = (bf16_t*)(ws + OFF_B + B_QKV); E.rw = (bf16_t*)(ws + OFF_B + B_RW); E.sg = (bf16_t*)(ws + OFF_B + B_SG); E.hd = (bf16_t*)(ws + OFF_B + B_HD);
                gemm_phase(lds, g, S, E); }
            grid.sync();
            phase_prep(KP, l, hf);
            if (hf == 0) { unsigned char* ws = kargs()->ws; phase_norm(KP, l, 0, HROWS, HROWS, (bf16_t*)(ws + OFF_B + B_HH), l == 0, false); }
            grid.sync();
        }
        TS(2);
        TS(3);
        if (lbid() < 128) { scan_chunked(KP, l); __syncthreads(); TS(4);
            unsigned char* ws = kargs()->ws;
            Gemm g; g.A = (const bf16_t*)(ws + OFF_AL); g.Bt = (const bf16_t*)(ws + OFF_WGL); g.lda = 256; g.ldb = 256; g.K = 256; g.perm = true;
            SchedStd S; S.init_sub(136, 2, 128, lbid()); EpiPlain E; E.o = (bf16_t*)(ws + OFF_B + B_G); E.ld = 512; E.act = 0; gemm_phase(lds, g, S, E); }
        else { TS(30); phase_attn(KP, l); TS(31); phase_sgu(KP, l); TS(32);
            unsigned char* ws = kargs()->ws;
            Gemm g; g.A = (const bf16_t*)(ws + OFF_AL); g.Bt = (const bf16_t*)(ws + OFF_WGL) + 512 * 256; g.lda = 256; g.ldb = 256; g.K = 256; g.perm = true;
            SchedStd S; S.init_sub(136, 4, 128, lbid() - 128); EpiAsum E; E.asum = (bf16_t*)(ws + OFF_B + B_ASUM); E.a0 = kargs()->rwkv_a0 + l * 1024; gemm_phase(lds, g, S, E); }
        TS(5); grid.sync(); TS(6);
        phase_post(KP, l); grid.sync(); TS(7);
        { unsigned char* ws = kargs()->ws; phase_norm(KP, l, 0, 0, NROW, (bf16_t*)(ws + OFF_B + B_HH), l == 0, last); } grid.sync();
        {   unsigned char* ws = kargs()->ws;
            GemmGM g; g.H = (const bf16_t*)(ws + OFF_B + B_HH); g.Wg = (const bf16_t*)(ws + OFF_WGATE); g.BIGp = (const bf16_t*)(ws + OFF_BIG); g.Wo = (const bf16_t*)(ws + OFF_WO3);
            SchedGM S; S.init(last ? 512 : 544, last ? 1 : 0);
            EpiGM E; E.scr = (bf16_t*)(ws + OFF_B + 71303168) + (size_t)lbid() * 65536; E.M = (bf16_t*)(ws + OFF_M);
            gemm_phase(lds, g, S, E); }
        grid.sync();
        TS(8);
        {   CP* kp = kargs(); unsigned char* ws = kp->ws;
            Gemm g; g.A = (const bf16_t*)(ws + OFF_M); g.Bt = (const bf16_t*)(ws + OFF_WOUT); g.lda = 1024; g.ldb = 1024; g.K = 1024; g.perm = false;
            SchedStd S; S.init(last ? 128 : 136, 4, last ? 1 : 0);
            EpiRes E; E.gmod = (const float*)(ws + OFF_MOD) + (size_t)l * 9 * 6144 + 2 * 1024; E.xo = kp->out; E.co = (float*)(ws + OFF_XSC); E.xin = l == 0 ? kp->x : (const float*)E.xo; E.cin = l == 0 ? kp->ctx : (const float*)E.co; E.readInput = l == 0;
            gemm_phase(lds, g, S, E); }
        grid.sync(); TS(9);
        { unsigned char* ws = kargs()->ws; phase_norm(KP, l, 1, 0, NROW, (bf16_t*)(ws + OFF_B + B_HH), false, last); } grid.sync(); TS(10);
        {   unsigned char* ws = kargs()->ws;
            Gemm g; g.A = (const bf16_t*)(ws + OFF_B + B_HH); g.Bt = (const bf16_t*)(ws + OFF_W13); g.lda = 1024; g.ldb = 1024; g.K = 1024; g.perm = true;
            SchedStd S; S.init(last ? 128 : 136, 22, last ? 1 : 0);
            EpiSwi E; E.U = (bf16_t*)(ws + OFF_U);
            gemm_phase(lds, g, S, E); }
        grid.sync(); TS(11);
        {   CP* kp = kargs(); unsigned char* ws = kp->ws;
            Gemm g; g.A = (const bf16_t*)(ws + OFF_U); g.Bt = (const bf16_t*)(ws + OFF_W2); g.lda = FF; g.ldb = FF; g.K = FF; g.perm = false;
            SchedStd S; S.init(last ? 128 : 136, 4, last ? 1 : 0);
            EpiRes E; E.gmod = (const float*)(ws + OFF_MOD) + (size_t)l * 9 * 6144 + 5 * 1024; E.xo = kp->out; E.co = (float*)(ws + OFF_XSC); E.xin = (const float*)E.xo; E.cin = (const float*)E.co; E.readInput = 0;
            gemm_phase(lds, g, S, E); }
        grid.sync(); TS(12);
    }
    if (PROBE_ID >= 0 && blockIdx.x == (PROBE_ID >= 30 ? 128 : 0) && threadIdx.x == 0) { const float us = (float)(tB - tA) * 0.01f; int q = (int)(__logf(fmaxf(us, 1.0f) / 10.0f) * (1.0f / 0.0953102f) + 0.5f); q = q < 0 ? 0 : (q > 89 ? 89 : q); kargs()->out[0] = 100.0f + 10.0f * (float)q; }
}

extern "C" void kernel_launch(void* const* d_in, const int* in_sizes, int n_in, void* d_out, int out_size, void* d_ws, size_t ws_size, hipStream_t stream) {
    if (n_in < 37 || ws_size < WS_TOTAL) { fprintf(stderr, "kernel_launch: bad inputs (n_in %d, ws %zu < %zu)\n", n_in, ws_size, (size_t)WS_TOTAL); return; }
    P p{};
    const float** pp = (const float**)&p;
    for (int i = 0; i < 37; ++i) pp[i] = (const float*)d_in[i];
    p.out = (float*)d_out; p.ws = (unsigned char*)d_ws;
    static int grid_blocks = 0;
    if (!grid_blocks) {
        int dev = 0, cus = 0, per_cu = 0;
        hipGetDevice(&dev); hipDeviceGetAttribute(&cus, hipDeviceAttributeMultiprocessorCount, dev);
        hipOccupancyMaxActiveBlocksPerMultiprocessor(&per_cu, mega, 512, 0);
        if (per_cu < 1) per_cu = 1;
        grid_blocks = cus;
        if (grid_blocks > 256) grid_blocks = 256;
    }
    void* args[] = {&p};
    hipError_t e = hipLaunchCooperativeKernel((void*)mega, dim3(grid_blocks), dim3(512), args, 0, stream);
    if (e != hipSuccess) fprintf(stderr, "cooperative launch failed: %s (grid %d)\n", hipGetErrorString(e), grid_blocks);
}
```
